# Optimizing an MI355X kernel written in HIP

```python
import math
import jax, jax.numpy as jnp
from jax import lax
import numpy as np

D_MODEL = 2048
BATCH = 4
SEQ = 2048
DEPTH = 2
DEC_BATCH = 128
DEC_SEQ = 8
PAST_LEN = 16384
PAGE_SIZE = 128

N_AB = (DEPTH + 1) // 2
N_ML = DEPTH // 2
EPS = 1e-6

GLA_HEADS = 4
GLA_DV = (D_MODEL // 2) // GLA_HEADS
GLA_DK = GLA_DV // 2
GLA_RANK = 16
GLA_GATE_NORM = 16.0
GLA_CHUNK = 64
GLA_QK = GLA_HEADS * GLA_DK
GLA_V = GLA_HEADS * GLA_DV

S5_WIDTH = D_MODEL // 2
S5_GROUP = 16
S5_GROUPS = S5_WIDTH // S5_GROUP
S5_STATE = 64

ML_HEADS = 4
ML_DV = D_MODEL // ML_HEADS
ML_DQK = ML_DV // 2
ML_CHUNK = 64
ML_QK = ML_HEADS * ML_DQK
ML_V = ML_HEADS * ML_DV

D_FF = ((8 * D_MODEL + 3 * 256 - 1) // (3 * 256)) * 256

AB_SPLITS = (GLA_QK, 2 * GLA_QK, 2 * GLA_QK + GLA_V, 2 * GLA_QK + 2 * GLA_V, 2 * GLA_QK + 2 * GLA_V + GLA_RANK)
AB_IN = AB_SPLITS[-1] + S5_WIDTH
AB_OUT = GLA_V + S5_WIDTH
ML_SPLITS = (ML_QK, 2 * ML_QK, 2 * ML_QK + ML_V, 2 * ML_QK + 2 * ML_V, 2 * ML_QK + 2 * ML_V + ML_HEADS)
ML_IN = ML_SPLITS[-1] + ML_HEADS

kernel_name = "hybrid_gla_s5_mlstm_adaln_step"


def rmsnorm(x, g):
    xf = x.astype(jnp.float32)
    return xf * lax.rsqrt(jnp.mean(xf * xf, axis=-1, keepdims=True) + EPS) * g.astype(jnp.float32)


def head_rmsnorm(x, g):
    return x * lax.rsqrt(jnp.mean(x * x, axis=-1, keepdims=True) + EPS) * g.astype(jnp.float32)


def modulate(x, c, ada_w, ada_b, norm_g):
    mod = jax.nn.silu(c.astype(jnp.float32)) @ ada_w + ada_b
    shift, scale, gate = jnp.split(mod[:, None, :], 3, axis=-1)
    return rmsnorm(x, norm_g) * (1.0 + scale) + shift, gate


def swiglu(h, w1, w3, w2):
    return (jax.nn.silu(h @ w1) * (h @ w3)) @ w2


def _chunks(a, n_chunks, size):
    return jnp.swapaxes(a.reshape(a.shape[0], n_chunks, size, *a.shape[2:]), 0, 1)


def _unchunks(a):
    a = jnp.swapaxes(a, 0, 1)
    return a.reshape(a.shape[0], a.shape[1] * a.shape[2], *a.shape[3:])


def gla_mix(q, k, v, log_a, s0):
    t = q.shape[1]
    size = math.gcd(t, GLA_CHUNK)
    nc = t // size
    causal = jnp.tril(jnp.ones((size, size), dtype=bool))[None, :, :, None, None]

    def step(s, xs):
        qc, kc, vc, gc = xs
        b = jnp.cumsum(gc, axis=1)
        diff = jnp.where(causal, b[:, :, None] - b[:, None, :], -jnp.inf)
        att = jnp.einsum("bthd,bshd,btshd->bhts", qc, kc, jnp.exp(diff))
        o = jnp.einsum("bhts,bshv->bthv", att, vc) + jnp.einsum("bthd,bhdv->bthv", qc * jnp.exp(b), s)
        b_last = b[:, -1]
        s_new = jnp.exp(b_last)[..., None] * s + jnp.einsum(
            "bshd,bshv->bhdv", kc * jnp.exp(b_last[:, None] - b), vc)
        return s_new, o

    s_fin, o = lax.scan(step, s0, (_chunks(q, nc, size), _chunks(k, nc, size),
                                   _chunks(v, nc, size), _chunks(log_a, nc, size)))
    return _unchunks(o), s_fin


def s5_mix(u, lam_re, lam_im, log_dt, b_re, b_im, c_re, c_im, d_skip, h0_re, h0_im):
    f32 = jnp.float32
    lam_re = lam_re.astype(f32)
    lam_im = lam_im.astype(f32)
    dt = jnp.exp(log_dt.astype(f32))[:, None]
    mag = jnp.exp(lam_re * dt)
    a_re = mag * jnp.cos(lam_im * dt)
    a_im = mag * jnp.sin(lam_im * dt)
    den = lam_re * lam_re + lam_im * lam_im
    f_re = ((a_re - 1.0) * lam_re + a_im * lam_im) / den
    f_im = (a_im * lam_re - (a_re - 1.0) * lam_im) / den
    bb_re = f_re[..., None] * b_re - f_im[..., None] * b_im
    bb_im = f_re[..., None] * b_im + f_im[..., None] * b_re
    bu_re = jnp.einsum("btgc,gpc->btgp", u, bb_re)
    bu_im = jnp.einsum("btgc,gpc->btgp", u, bb_im)
    bu_re = bu_re.at[:, 0].add(a_re * h0_re - a_im * h0_im)
    bu_im = bu_im.at[:, 0].add(a_re * h0_im + a_im * h0_re)
    ar = jnp.broadcast_to(a_re, bu_re.shape)
    ai = jnp.broadcast_to(a_im, bu_im.shape)

    def combine(e1, e2):
        a1r, a1i, b1r, b1i = e1
        a2r, a2i, b2r, b2i = e2
        return (a2r * a1r - a2i * a1i,
                a2r * a1i + a2i * a1r,
                a2r * b1r - a2i * b1i + b2r,
                a2r * b1i + a2i * b1r + b2i)

    _, _, h_re, h_im = lax.associative_scan(combine, (ar, ai, bu_re, bu_im), axis=1)
    y = (jnp.einsum("btgp,gcp->btgc", h_re, c_re) - jnp.einsum("btgp,gcp->btgc", h_im, c_im)
         + d_skip * u)
    return y, h_re[:, -1], h_im[:, -1]


def mlstm_mix(q, k, v, i_pre, logf, c0, n0, m0):
    t = q.shape[1]
    size = math.gcd(t, ML_CHUNK)
    nc = t // size
    causal = jnp.tril(jnp.ones((size, size), dtype=bool))[None, :, :, None]

    def step(carry, xs):
        cm, nv, m = carry
        qc, kc, vc, ic, fc = xs
        b = jnp.cumsum(fc, axis=1)
        lw = jnp.where(causal, b[:, :, None] - b[:, None, :] + ic[:, None, :], -jnp.inf)
        l_inter = b + m[:, None]
        m_t = jnp.maximum(l_inter, jnp.max(lw, axis=2))
        w = jnp.exp(lw - m_t[:, :, None])
        g_inter = jnp.exp(l_inter - m_t)
        sw = jnp.einsum("bthd,bshd->btsh", qc, kc) * w
        num = jnp.einsum("btsh,bshv->bthv", sw, vc) + g_inter[..., None] * jnp.einsum("bhvd,bthd->bthv", cm, qc)
        den = jnp.sum(sw, axis=2) + g_inter * jnp.einsum("bhd,bthd->bth", nv, qc)
        h = num / jnp.maximum(jnp.abs(den), jnp.exp(-m_t))[..., None]
        b_last = b[:, -1]
        l_src = b_last[:, None] - b + ic
        m_new = jnp.maximum(b_last + m, jnp.max(l_src, axis=1))
        ws = jnp.exp(l_src - m_new[:, None])
        decay = jnp.exp(b_last + m - m_new)
        c_new = decay[..., None, None] * cm + jnp.einsum("bsh,bshv,bshd->bhvd", ws, vc, kc)
        n_new = decay[..., None] * nv + jnp.einsum("bsh,bshd->bhd", ws, kc)
        return (c_new, n_new, m_new), h

    (c_f, n_f, m_f), h = lax.scan(step, (c0, n0, m0), (
        _chunks(q, nc, size), _chunks(k, nc, size), _chunks(v, nc, size),
        _chunks(i_pre, nc, size), _chunks(logf, nc, size)))
    return _unchunks(h), c_f, n_f, m_f


def trunk(x, c, st_gla, st_re, st_im, st_c, st_n, st_m, p):
    f32 = jnp.float32
    bsz, t, _ = x.shape
    new_gla, new_re, new_im, new_c, new_n, new_m = [], [], [], [], [], []
    for li in range(DEPTH):
        j = li // 2
        if li % 2 == 0:
            h, gate = modulate(x, c, p["ab_ada_w"][j], p["ab_ada_b"][j], p["ab_norm_g"][j])
            z = (h @ p["ab_w_in"][j]).astype(f32)
            q, k, v, r, g_lr, u = jnp.split(z, AB_SPLITS, axis=-1)
            q = q.reshape(bsz, t, GLA_HEADS, GLA_DK) * GLA_DK ** -0.5
            k = k.reshape(bsz, t, GLA_HEADS, GLA_DK)
            v = v.reshape(bsz, t, GLA_HEADS, GLA_DV)
            log_a = (jax.nn.log_sigmoid(g_lr @ p["gla_w_gate"][j] + p["gla_b_gate"][j])
                     / GLA_GATE_NORM).reshape(bsz, t, GLA_HEADS, GLA_DK)
            o, s_gla = gla_mix(q, k, v, log_a, st_gla[j].astype(f32))
            o = head_rmsnorm(o, p["gla_norm_g"][j]) * jax.nn.silu(r.reshape(bsz, t, GLA_HEADS, GLA_DV))
            y, h_re, h_im = s5_mix(u.reshape(bsz, t, S5_GROUPS, S5_GROUP),
                                   p["s5_lam_re"][j], p["s5_lam_im"][j], p["s5_log_dt"][j],
                                   p["s5_b_re"][j], p["s5_b_im"][j], p["s5_c_re"][j], p["s5_c_im"][j],
                                   p["s5_d"][j], st_re[j].astype(f32), st_im[j].astype(f32))
            y = jax.nn.gelu(y.reshape(bsz, t, S5_WIDTH))
            y = y * jax.nn.sigmoid(y @ p["s5_w_glu"][j] + p["s5_b_glu"][j])
            out = jnp.concatenate([o.reshape(bsz, t, GLA_V), y], axis=-1) @ p["ab_w_out"][j]
            x = x + (gate * out).astype(x.dtype)
            new_gla.append(s_gla)
            new_re.append(h_re)
            new_im.append(h_im)
        else:
            h, gate = modulate(x, c, p["ml_ada_w"][j], p["ml_ada_b"][j], p["ml_norm_g"][j])
            z = (h @ p["ml_w_in"][j]).astype(f32)
            q, k, v, og, ig, fg = jnp.split(z, ML_SPLITS, axis=-1)
            q = q.reshape(bsz, t, ML_HEADS, ML_DQK)
            k = k.reshape(bsz, t, ML_HEADS, ML_DQK) * ML_DQK ** -0.5
            v = v.reshape(bsz, t, ML_HEADS, ML_DV)
            i_pre = ig + p["ml_b_i"][j]
            logf = jax.nn.log_sigmoid(fg + p["ml_b_f"][j])
            hh, c1, n1, m1 = mlstm_mix(q, k, v, i_pre, logf, st_c[j].astype(f32),
                                       st_n[j].astype(f32), st_m[j].astype(f32))
            hh = head_rmsnorm(hh, p["ml_out_norm_g"][j]) * jax.nn.sigmoid(og.reshape(bsz, t, ML_HEADS, ML_DV))
            out = hh.reshape(bsz, t, ML_V) @ p["ml_w_out"][j]
            x = x + (gate * out).astype(x.dtype)
            new_c.append(c1)
            new_n.append(n1)
            new_m.append(m1)
        h, gate = modulate(x, c, p["ffn_ada_w"][li], p["ffn_ada_b"][li], p["ffn_norm_g"][li])
        x = x + (gate * swiglu(h, p["ffn_w1"][li], p["ffn_w3"][li], p["ffn_w2"][li])).astype(x.dtype)
    y = rmsnorm(x, p["final_norm_g"]).astype(x.dtype)
    return (y, jnp.stack(new_gla), jnp.stack(new_re), jnp.stack(new_im),
            jnp.stack(new_c), jnp.stack(new_n), jnp.stack(new_m))


def setup_inputs(seed: int = 0) -> dict:
    key = jax.random.key(seed)
    keys = list(jax.random.split(key, 64))
    it = iter(keys)

    def nrm(shape, scale):
        return jax.random.normal(next(it), shape, jnp.float32) * scale

    D = D_MODEL
    ada_scale = 0.5 * D ** -0.5
    lam_im0 = jnp.pi * jnp.arange(S5_STATE, dtype=jnp.float32)
    f_bias0 = jnp.linspace(3.0, 6.0, ML_HEADS, dtype=jnp.float32)
    inp = {
        "x_prompt": nrm((BATCH, SEQ, D), 1.0),
        "x_sample": nrm((DEC_BATCH, DEC_SEQ, D), 1.0),
        "c_prompt": nrm((BATCH, D), 1.0),
        "c_sample": nrm((DEC_BATCH, D), 1.0),
        "state_gla": nrm((N_AB, DEC_BATCH, GLA_HEADS, GLA_DK, GLA_DV), 0.5),
        "state_s5_re": nrm((N_AB, DEC_BATCH, S5_GROUPS, S5_STATE), 0.3),
        "state_s5_im": nrm((N_AB, DEC_BATCH, S5_GROUPS, S5_STATE), 0.3),
        "state_mlstm_C": nrm((N_ML, DEC_BATCH, ML_HEADS, ML_DV, ML_DQK), 0.1),
        "state_mlstm_n": nrm((N_ML, DEC_BATCH, ML_HEADS, ML_DQK), 0.1),
        "state_mlstm_m": nrm((N_ML, DEC_BATCH, ML_HEADS), 1.0),
        "ab_ada_w": nrm((N_AB, D, 3 * D), ada_scale),
        "ab_ada_b": nrm((N_AB, 3 * D), 0.02),
        "ab_norm_g": 1.0 + nrm((N_AB, D), 0.02),
        "ab_w_in": nrm((N_AB, D, AB_IN), D ** -0.5),
        "gla_w_gate": nrm((N_AB, GLA_RANK, GLA_QK), GLA_RANK ** -0.5),
        "gla_b_gate": 1.0 + nrm((N_AB, GLA_QK), 0.5),
        "gla_norm_g": 1.0 + nrm((N_AB, GLA_HEADS, GLA_DV), 0.02),
        "s5_lam_re": -0.5 + nrm((N_AB, S5_GROUPS, S5_STATE), 0.01),
        "s5_lam_im": lam_im0 + nrm((N_AB, S5_GROUPS, S5_STATE), 0.01),
        "s5_log_dt": jax.random.uniform(next(it), (N_AB, S5_GROUPS), jnp.float32,
                                        minval=math.log(1e-3), maxval=math.log(1e-1)),
        "s5_b_re": nrm((N_AB, S5_GROUPS, S5_STATE, S5_GROUP), (2 * S5_GROUP) ** -0.5),
        "s5_b_im": nrm((N_AB, S5_GROUPS, S5_STATE, S5_GROUP), (2 * S5_GROUP) ** -0.5),
        "s5_c_re": nrm((N_AB, S5_GROUPS, S5_GROUP, S5_STATE), S5_STATE ** -0.5),
        "s5_c_im": nrm((N_AB, S5_GROUPS, S5_GROUP, S5_STATE), S5_STATE ** -0.5),
        "s5_d": nrm((N_AB, S5_GROUPS, S5_GROUP), 0.5),
        "s5_w_glu": nrm((N_AB, S5_WIDTH, S5_WIDTH), S5_WIDTH ** -0.5),
        "s5_b_glu": nrm((N_AB, S5_WIDTH), 0.02),
        "ab_w_out": nrm((N_AB, AB_OUT, D), AB_OUT ** -0.5),
        "ml_ada_w": nrm((N_ML, D, 3 * D), ada_scale),
        "ml_ada_b": nrm((N_ML, 3 * D), 0.02),
        "ml_norm_g": 1.0 + nrm((N_ML, D), 0.02),
        "ml_w_in": nrm((N_ML, D, ML_IN), D ** -0.5),
        "ml_b_i": nrm((N_ML, ML_HEADS), 0.1),
        "ml_b_f": f_bias0 + nrm((N_ML, ML_HEADS), 0.1),
        "ml_out_norm_g": 1.0 + nrm((N_ML, ML_HEADS, ML_DV), 0.02),
        "ml_w_out": nrm((N_ML, ML_V, D), ML_V ** -0.5),
        "ffn_ada_w": nrm((DEPTH, D, 3 * D), ada_scale),
        "ffn_ada_b": nrm((DEPTH, 3 * D), 0.02),
        "ffn_norm_g": 1.0 + nrm((DEPTH, D), 0.02),
        "ffn_w1": nrm((DEPTH, D, D_FF), D ** -0.5),
        "ffn_w3": nrm((DEPTH, D, D_FF), D ** -0.5),
        "ffn_w2": nrm((DEPTH, D_FF, D), D_FF ** -0.5),
        "final_norm_g": 1.0 + nrm((D,), 0.02),
    }
    return inp


def reference(x_prompt, x_sample, c_prompt, c_sample,
              state_gla, state_s5_re, state_s5_im, state_mlstm_C, state_mlstm_n, state_mlstm_m,
              ab_ada_w, ab_ada_b, ab_norm_g, ab_w_in, gla_w_gate, gla_b_gate, gla_norm_g,
              s5_lam_re, s5_lam_im, s5_log_dt, s5_b_re, s5_b_im, s5_c_re, s5_c_im, s5_d,
              s5_w_glu, s5_b_glu, ab_w_out,
              ml_ada_w, ml_ada_b, ml_norm_g, ml_w_in, ml_b_i, ml_b_f, ml_out_norm_g, ml_w_out,
              ffn_ada_w, ffn_ada_b, ffn_norm_g, ffn_w1, ffn_w3, ffn_w2, final_norm_g):
    p = {
        "ab_ada_w": ab_ada_w, "ab_ada_b": ab_ada_b, "ab_norm_g": ab_norm_g, "ab_w_in": ab_w_in,
        "gla_w_gate": gla_w_gate, "gla_b_gate": gla_b_gate, "gla_norm_g": gla_norm_g,
        "s5_lam_re": s5_lam_re, "s5_lam_im": s5_lam_im, "s5_log_dt": s5_log_dt,
        "s5_b_re": s5_b_re, "s5_b_im": s5_b_im, "s5_c_re": s5_c_re, "s5_c_im": s5_c_im, "s5_d": s5_d,
        "s5_w_glu": s5_w_glu, "s5_b_glu": s5_b_glu, "ab_w_out": ab_w_out,
        "ml_ada_w": ml_ada_w, "ml_ada_b": ml_ada_b, "ml_norm_g": ml_norm_g, "ml_w_in": ml_w_in,
        "ml_b_i": ml_b_i, "ml_b_f": ml_b_f, "ml_out_norm_g": ml_out_norm_g, "ml_w_out": ml_w_out,
        "ffn_ada_w": ffn_ada_w, "ffn_ada_b": ffn_ada_b, "ffn_norm_g": ffn_norm_g,
        "ffn_w1": ffn_w1, "ffn_w3": ffn_w3, "ffn_w2": ffn_w2, "final_norm_g": final_norm_g,
    }
    f32 = jnp.float32
    bp = x_prompt.shape[0]
    (y_prompt, gla_p, s5_re_p, s5_im_p, mlstm_C_p, mlstm_n_p, mlstm_m_p) = trunk(
        x_prompt, c_prompt,
        jnp.zeros((N_AB, bp, GLA_HEADS, GLA_DK, GLA_DV), f32),
        jnp.zeros((N_AB, bp, S5_GROUPS, S5_STATE), f32),
        jnp.zeros((N_AB, bp, S5_GROUPS, S5_STATE), f32),
        jnp.zeros((N_ML, bp, ML_HEADS, ML_DV, ML_DQK), f32),
        jnp.zeros((N_ML, bp, ML_HEADS, ML_DQK), f32),
        jnp.zeros((N_ML, bp, ML_HEADS), f32), p)
    (y_sample, gla_s, s5_re_s, s5_im_s, mlstm_C_s, mlstm_n_s, mlstm_m_s) = trunk(
        x_sample, c_sample, state_gla, state_s5_re, state_s5_im,
        state_mlstm_C, state_mlstm_n, state_mlstm_m, p)
    return (y_prompt, y_sample,
            gla_p, s5_re_p, s5_im_p, mlstm_C_p, mlstm_n_p, mlstm_m_p,
            gla_s, s5_re_s, s5_im_s, mlstm_C_s, mlstm_n_s, mlstm_m_s)
```

```cpp
#include <hip/hip_runtime.h>
#include <hip/hip_cooperative_groups.h>
#include <cstdio>
#include <cstdint>
namespace cg = cooperative_groups;

#ifndef MK_PER_PHASE
#define MK_PER_PHASE 0
#endif

#define LAS __attribute__((address_space(3)))
typedef unsigned short bf16_t;
typedef short bf16x8 __attribute__((ext_vector_type(8)));
typedef float f32x4 __attribute__((ext_vector_type(4)));
typedef float f32x2 __attribute__((ext_vector_type(2)));
typedef unsigned u32x4 __attribute__((ext_vector_type(4)));
typedef unsigned u32x2 __attribute__((ext_vector_type(2)));

constexpr int DM = 2048, NPROMPT = 8192, MROWS = 9216, NSEQ = 132, DFF = 5632;
constexpr int NPH = 19;
constexpr int LDS_BYTES = 147456;
constexpr int NTHREADS = 512;
constexpr float EPS = 1e-6f;

constexpr size_t OFF_WADA = 0;
constexpr size_t OFF_WABIN = OFF_WADA + 100663296;
constexpr size_t OFF_WGLU = OFF_WABIN + 16777216;
constexpr size_t OFF_WABOUT = OFF_WGLU + 2097152;
constexpr size_t OFF_WF13 = OFF_WABOUT + 8388608;
constexpr size_t OFF_WF2 = OFF_WF13 + 92274688;
constexpr size_t OFF_WMLIN = OFF_WF2 + 46137344;
constexpr size_t OFF_WMLOUT = OFF_WMLIN + 25165824;
constexpr size_t OFF_WGLR = OFF_WMLOUT + 8388608;
constexpr size_t OFF_WMLG = OFF_WGLR + 131072;
constexpr size_t OFF_CS = OFF_WMLG + 65536;
constexpr size_t OFF_MOD = OFF_CS + 1048576;
constexpr size_t OFF_XCUR = OFF_MOD + 25165824;
constexpr size_t OFF_HA = OFF_XCUR + 75497472;
constexpr size_t OFF_Z = OFF_HA + 37748736;
constexpr size_t OFF_LA = OFF_Z + 113246208;
constexpr size_t OFF_GT = OFF_LA + 18874368;
constexpr size_t OFF_OBUF = OFF_GT + 294912;
constexpr size_t OFF_YG = OFF_OBUF + 75497472;
constexpr size_t OFF_MIX = OFF_YG + 18874368;
constexpr size_t OFF_HH = OFF_MIX + 37748736;
constexpr size_t OFF_BADA = OFF_HH + 103809024;
constexpr size_t OFF_PART = OFF_BADA + 98304;
constexpr size_t OFF_CTL = OFF_PART + 67108864;
constexpr size_t CTL_BYTES = 16384;
constexpr size_t WS_END = OFF_CTL + CTL_BYTES;

constexpr size_t O_YP = 0, O_YS = 16777216, O_GLAP = 18874368, O_S5REP = 19398656, O_S5IMP = 19415040, O_MLCP = 19431424,
                 O_MLNP = 21528576, O_MLMP = 21532672, O_GLAS = 21532688, O_S5RES = 38309904, O_S5IMS = 38834192,
                 O_MLCS = 39358480, O_MLNS = 106467344, O_MLMS = 106598416, O_END = 106598928;

enum { I_XP = 0, I_XS, I_CP, I_CS, I_SGLA, I_SS5RE, I_SS5IM, I_SMLC, I_SMLN, I_SMLM, I_ABADAW, I_ABADAB, I_ABNG, I_ABWIN, I_GLAWG, I_GLABG,
       I_GLANG, I_S5LRE, I_S5LIM, I_S5LDT, I_S5BRE, I_S5BIM, I_S5CRE, I_S5CIM, I_S5D, I_S5WGLU, I_S5BGLU, I_ABWOUT, I_MLADAW, I_MLADAB,
       I_MLNG, I_MLWIN, I_MLBI, I_MLBF, I_MLONG, I_MLWOUT, I_FADAW, I_FADAB, I_FNG, I_FW1, I_FW3, I_FW2, I_FINALG, N_IN };

struct Params { const float* in[N_IN]; float* out; unsigned char* ws; int ph_lo, ph_hi; };

__device__ __forceinline__ float wave_sum(float v) {
#pragma unroll
    for (int o = 1; o < 64; o <<= 1) v += __shfl_xor(v, o);
    return v;
}
__device__ __forceinline__ unsigned cvt_pk_bf16(float lo, float hi) { unsigned r; asm volatile("v_cvt_pk_bf16_f32 %0, %1, %2" : "=v"(r) : "v"(lo), "v"(hi)); return r; }
__device__ __forceinline__ bf16_t f2bf(float f) { return (bf16_t)(cvt_pk_bf16(f, 0.f) & 0xffffu); }
__device__ __forceinline__ float bf2f(unsigned b) { return __uint_as_float(b << 16); }
__device__ __forceinline__ float bflo(unsigned w) { return __uint_as_float(w << 16); }
__device__ __forceinline__ float bfhi(unsigned w) { return __uint_as_float(w & 0xffff0000u); }
__device__ __forceinline__ float sigmoidf_(float x) { return __builtin_amdgcn_rcpf(1.f + __expf(-x)); }
__device__ __forceinline__ float siluf_(float x) { return x * __builtin_amdgcn_rcpf(1.f + __expf(-x)); }
__device__ __forceinline__ float logsigmoidf_(float x) { return fminf(x, 0.f) - __logf(1.f + __expf(-fabsf(x))); }
__device__ __forceinline__ float gelu_tanh(float y) { const float u = 0.7978845608028654f * (y + 0.044715f * y * y * y); const float t = 1.f - 2.f * __builtin_amdgcn_rcpf(__expf(2.f * u) + 1.f); return 0.5f * y * (1.f + t); }
__device__ __forceinline__ int row_seq(int row) { return row < NPROMPT ? (row >> 11) : 4 + ((row - NPROMPT) >> 3); }
__device__ __forceinline__ bf16x8 mk8(unsigned a, unsigned b, unsigned c, unsigned d) { u32x4 v = {a, b, c, d}; return __builtin_bit_cast(bf16x8, v); }
#define MFMA16(a, b, c) __builtin_amdgcn_mfma_f32_16x16x32_bf16((a), (b), (c), 0, 0, 0)
#define LDS_FENCE() asm volatile("s_waitcnt lgkmcnt(0)" ::: "memory")

namespace pg8 {
constexpr int BM = 256, BK = 64, HALF = 128, HTB = HALF * BK * 2, NXCD = 8, WGM = 8;
__host__ __device__ __forceinline__ int lds_byte(int r, int c) { const int st = (r >> 4) * 2 + (c >> 5), rr = r & 15, cc = c & 31, ob = rr * 64 + cc * 2; return st * 1024 + (ob ^ (((ob >> 9) & 1) << 5)); }
__host__ __device__ __forceinline__ void stage_rc(int b, int& R, int& C) { const int st = b / 1024, sb = b % 1024, swz = sb ^ (((sb >> 9) & 1) << 5); R = (st >> 1) * 16 + swz / 64; C = (st & 1) * 32 + (swz % 64) / 2; }
__host__ __device__ __forceinline__ int perm32(int rho) { const int n = rho >> 4, i = rho & 15; return 8 * (i >> 2) + 4 * n + (i & 3); }
struct Unit { int pm, pn, kt0, nkt, ks; };
struct Gemm { const bf16_t* A; const bf16_t* Bt; int M, N, K; };
struct StaticOrder {
    int nM, nN, nwg, G, c, nkt;
    __device__ void init(int M, int N, int K, int G_, int c_) { nM = M / BM; nN = N / BM; nwg = nM * nN; G = G_; c = c_; nkt = K / BK; }
    __device__ bool next(int i, Unit& u) const {
        const long L = (long)i * G + c; if (L >= nwg) return false;
        int wgid = (int)L; { const int q = nwg / NXCD, r = nwg % NXCD, xcd = wgid % NXCD, off = wgid / NXCD; wgid = (xcd < r ? xcd * (q + 1) : r * (q + 1) + (xcd - r) * q) + off; }
        const int nig = WGM * nN, gid = wgid / nig, fm = gid * WGM, gsz = (nM - fm) < WGM ? (nM - fm) : WGM;
        u.pm = fm + ((wgid % nig) % gsz); u.pn = (wgid % nig) / gsz; u.kt0 = 0; u.nkt = nkt; u.ks = -1; return true;
    }
};
struct SplitOrder {
    int c, nkt, ok;
    __device__ void init(int K, int G_, int c_) { c = c_; nkt = K / BK; ok = (G_ == 256); }
    __device__ bool next(int i, Unit& u) const {
        if (i == 0) { const int xcd = c & 7, j = c >> 3; u.pm = xcd * 4 + (j >> 3); u.pn = j & 7; u.kt0 = 0; u.nkt = nkt; u.ks = -1; return true; }
        if (i == 1) { const int tl = c & 31, ks = c >> 5; u.pm = 32 + (tl >> 3); u.pn = tl & 7; u.ks = ks;
            if (nkt == 32) { u.kt0 = ks * 4; u.nkt = 4; } else { u.kt0 = (ks >> 1) * 22 + (ks & 1) * 12; u.nkt = (ks & 1) ? 10 : 12; }
            return true; }
        return false;
    }
};
struct UpOrder {
    int c, nkt;
    __device__ void init(int K, int c_) { c = c_; nkt = K / BK; }
    __device__ bool next(int i, Unit& u) const {
        const int L = i * 256 + c;
        if (L < 1496) { const int nM = 34, nN = 44, nwg = 1496;
            int wgid = L; { const int q = nwg / NXCD, r = nwg % NXCD, xcd = wgid % NXCD, off = wgid / NXCD; wgid = (xcd < r ? xcd * (q + 1) : r * (q + 1) + (xcd - r) * q) + off; }
            const int nig = WGM * nN, gid = wgid / nig, fm = gid * WGM, gsz = (nM - fm) < WGM ? (nM - fm) : WGM;
            u.pm = fm + ((wgid % nig) % gsz); u.pn = (wgid % nig) / gsz; u.kt0 = 0; u.nkt = nkt; u.ks = -1; return true; }
        if (L < 1536) { u.pm = 34; u.pn = L - 1496; u.kt0 = 0; u.nkt = nkt; u.ks = -1; return true; }
        return false;
    }
};
struct UpRem {
    int c, nkt;
    __device__ void init(int K, int c_) { c = c_; nkt = K / BK; }
    __device__ bool next(int i, Unit& u) const {
        if (i != 0 || c >= 192) return false;
        const int tr = c % 48, ks = c / 48;
        if (tr < 44) { u.pm = 35; u.pn = tr; } else { u.pm = 34; u.pn = 40 + (tr - 44); }
        u.ks = ks; u.kt0 = ks * (nkt / 4); u.nkt = nkt / 4; return true;
    }
};
template <class Epi, class Sched>
__device__ __forceinline__ void gemm_phase(LAS unsigned char* lds, const Gemm g, const Sched& S, const Epi& E) {
    const int tid = threadIdx.x, wid = __builtin_amdgcn_readfirstlane(tid >> 6), lane = tid & 63, wr = wid >> 2, wc = wid & 3, fr = lane & 15, fq = lane >> 4;
    const int K = g.K;
    unsigned voffA[2], voffB[2];
#pragma unroll
    for (int i = 0; i < 2; ++i) { int R, C; stage_rc(tid * 16 + i * 8192, R, C); const int Rb = Epi::PERM ? ((R & ~31) + perm32(R & 31)) : R;
        voffA[i] = (unsigned)(R * K + C) * 2u; voffB[i] = (unsigned)(Rb * K + C) * 2u; }
    const size_t kstep = (size_t)(BK * 2);
    const size_t hstep = (size_t)HALF * K * 2;
    const size_t tstep = 2 * hstep;
    const unsigned ldsw = (unsigned)wid * 1024u;
    const int aoff = lds_byte(wr * 64 + fr, fq * 8), boff = lds_byte(wc * 32 + fr, fq * 8);
#define PG8_SA(b, h) (((b) * 2 + (h)) * HTB)
#define PG8_SB(b, h) ((4 + (b) * 2 + (h)) * HTB)
#define PG8_STAGE(bufoff, gbase, voff) do { _Pragma("unroll") for (int _i = 0; _i < 2; ++_i) \
        __builtin_amdgcn_global_load_lds((const unsigned*)((const char*)(gbase) + (voff)[_i]), (LAS unsigned*)(lds + (bufoff) + ldsw + _i * 8192), 16, 0, 0); } while (0)
#define PG8_LDA(dst, b, h) do { _Pragma("unroll") for (int m = 0; m < 4; ++m) _Pragma("unroll") for (int k = 0; k < 2; ++k) dst[m][k] = *(const LAS bf16x8*)(lds + PG8_SA(b, h) + aoff + m * 2048 + k * 1024); } while (0)
#define PG8_LDB(dst, b, h) do { _Pragma("unroll") for (int n = 0; n < 2; ++n) _Pragma("unroll") for (int k = 0; k < 2; ++k) dst[n][k] = *(const LAS bf16x8*)(lds + PG8_SB(b, h) + boff + n * 2048 + k * 1024); } while (0)
#define PG8_MMA(ai, bj, At, Bt) do { __builtin_amdgcn_s_setprio(1); _Pragma("unroll") for (int m = 0; m < 4; ++m) _Pragma("unroll") for (int n = 0; n < 2; ++n) _Pragma("unroll") for (int k = 0; k < 2; ++k) \
        acc[ai][bj][m][n] = __builtin_amdgcn_mfma_f32_16x16x32_bf16(Bt[n][k], At[m][k], acc[ai][bj][m][n], 0, 0, 0); __builtin_amdgcn_s_setprio(0); } while (0)
#define PG8_WAIT_V(n) asm volatile("s_waitcnt vmcnt(" #n ")" ::: "memory")
#define PG8_WAIT_L(n) asm volatile("s_waitcnt lgkmcnt(" #n ")" ::: "memory")
#define PG8_BAR __builtin_amdgcn_s_barrier()
#define PG8_SCHED __builtin_amdgcn_sched_barrier(0)
    Unit cur, nxt; int ui = 0;
    if (!S.next(0, cur)) return;
    f32x4 acc[2][2][4][2];
#pragma unroll
    for (int a = 0; a < 2; ++a)
#pragma unroll
        for (int b = 0; b < 2; ++b)
#pragma unroll
            for (int m = 0; m < 4; ++m)
#pragma unroll
                for (int n = 0; n < 2; ++n) acc[a][b][m][n] = (f32x4){0.f, 0.f, 0.f, 0.f};
    bf16x8 At[4][2], B0[2][2], B1[2][2];
    const char* cA = (const char*)g.A + (size_t)cur.pm * tstep + (size_t)cur.kt0 * kstep; const char* cB = (const char*)g.Bt + (size_t)cur.pn * tstep + (size_t)cur.kt0 * kstep;
    PG8_STAGE(PG8_SB(0, 0), cB, voffB); PG8_STAGE(PG8_SB(0, 1), cB + hstep, voffB); PG8_STAGE(PG8_SA(0, 0), cA, voffA); PG8_STAGE(PG8_SA(0, 1), cA + hstep, voffA);
    if (wr == 1) PG8_BAR;
    PG8_WAIT_V(2); PG8_BAR;
    PG8_STAGE(PG8_SB(1, 0), cB + kstep, voffB); PG8_STAGE(PG8_SA(1, 0), cA + kstep, voffA); PG8_STAGE(PG8_SB(1, 1), cB + hstep + kstep, voffB);
    PG8_WAIT_V(6); PG8_BAR;
    for (;;) {
        const bool has_next = S.next(ui + 1, nxt);
        const char* nA = has_next ? (const char*)g.A + (size_t)nxt.pm * tstep + (size_t)nxt.kt0 * kstep : cA; const char* nB = has_next ? (const char*)g.Bt + (size_t)nxt.pn * tstep + (size_t)nxt.kt0 * kstep : cB;
        const int nt = cur.nkt;
        for (int t = 0; t < nt; t += 2) {
            const bool last = (t == nt - 2);
            const char* a1 = cA + (size_t)(t + 1) * kstep;
            const char* a2 = last ? nA : cA + (size_t)(t + 2) * kstep; const char* b2 = last ? nB : cB + (size_t)(t + 2) * kstep;
            const char* a3 = a2 + kstep; const char* b3 = b2 + kstep;
            PG8_LDB(B0, 0, 0); PG8_LDB(B1, 0, 1); PG8_SCHED; PG8_LDA(At, 0, 0); PG8_STAGE(PG8_SA(1, 1), a1 + hstep, voffA);
            PG8_WAIT_V(8); PG8_WAIT_L(0); PG8_BAR; PG8_MMA(0, 0, At, B0); PG8_MMA(0, 1, At, B1); PG8_BAR; PG8_SCHED;
            PG8_LDA(At, 0, 1); PG8_STAGE(PG8_SB(0, 0), b2, voffB); PG8_STAGE(PG8_SB(0, 1), b2 + hstep, voffB); PG8_STAGE(PG8_SA(0, 0), a2, voffA);
            PG8_WAIT_V(8); PG8_WAIT_L(0); PG8_BAR; PG8_MMA(1, 0, At, B0); PG8_MMA(1, 1, At, B1); PG8_BAR; PG8_SCHED;
            PG8_LDB(B0, 1, 0); PG8_LDB(B1, 1, 1); PG8_SCHED; PG8_LDA(At, 1, 0); PG8_STAGE(PG8_SA(0, 1), a2 + hstep, voffA);
            PG8_WAIT_V(8); PG8_WAIT_L(0); PG8_BAR; PG8_MMA(0, 0, At, B0); PG8_MMA(0, 1, At, B1); PG8_BAR; PG8_SCHED;
            PG8_LDA(At, 1, 1); PG8_STAGE(PG8_SB(1, 0), b3, voffB); PG8_STAGE(PG8_SB(1, 1), b3 + hstep, voffB); PG8_STAGE(PG8_SA(1, 0), a3, voffA);
            PG8_WAIT_V(8); PG8_WAIT_L(0); PG8_BAR; PG8_MMA(1, 0, At, B0); PG8_MMA(1, 1, At, B1); PG8_BAR; PG8_SCHED;
        }
        if (wr == 0) PG8_BAR;
        E(acc, cur, wr, wc, fr, fq);
        if (!has_next) break;
#pragma unroll
        for (int a = 0; a < 2; ++a)
#pragma unroll
            for (int b = 0; b < 2; ++b)
#pragma unroll
                for (int m = 0; m < 4; ++m)
#pragma unroll
                    for (int n = 0; n < 2; ++n) acc[a][b][m][n] = (f32x4){0.f, 0.f, 0.f, 0.f};
        cur = nxt; cA = nA; cB = nB; ++ui;
        if (wr == 1) PG8_BAR;
    }
    PG8_WAIT_V(0);
    PG8_BAR;
#undef PG8_SA
#undef PG8_SB
#undef PG8_STAGE
#undef PG8_LDA
#undef PG8_LDB
#undef PG8_MMA
#undef PG8_WAIT_V
#undef PG8_WAIT_L
#undef PG8_BAR
#undef PG8_SCHED
}
}
using pg8::Unit;
typedef f32x4 AccT[2][2][4][2];

struct EpiAda {
    static constexpr bool PERM = false;
    float* mod; const float* bias;
    __device__ __forceinline__ void operator()(const AccT& acc, const Unit& u, int wr, int wc, int fr, int fq) const {
        const int colb = u.pn * 256 + wc * 32 + 4 * fq;
#pragma unroll
        for (int ai = 0; ai < 2; ++ai)
#pragma unroll
            for (int m = 0; m < 4; ++m) {
                const int row = u.pm * 256 + ai * 128 + wr * 64 + m * 16 + fr;
                if (row < NSEQ) {
#pragma unroll
                    for (int bj = 0; bj < 2; ++bj)
#pragma unroll
                        for (int n = 0; n < 2; ++n) { const int c = colb + bj * 128 + n * 16; const f32x4 bv = *(const f32x4*)(bias + c);
                            *(f32x4*)(mod + (size_t)row * 24576 + c) = acc[ai][bj][m][n] + bv; }
                }
            }
    }
};
struct EpiBf16 {
    static constexpr bool PERM = true;
    bf16_t* O; int ldc;
    __device__ __forceinline__ void operator()(const AccT& acc, const Unit& u, int wr, int wc, int fr, int fq) const {
        const int col0 = u.pn * 256 + wc * 32 + 8 * fq;
#pragma unroll
        for (int ai = 0; ai < 2; ++ai)
#pragma unroll
            for (int m = 0; m < 4; ++m) { bf16_t* rowp = O + (size_t)(u.pm * 256 + ai * 128 + wr * 64 + m * 16 + fr) * ldc + col0;
#pragma unroll
                for (int bj = 0; bj < 2; ++bj) { const f32x4 v0 = acc[ai][bj][m][0], v1 = acc[ai][bj][m][1];
                    u32x4 w; w.x = cvt_pk_bf16(v0[0], v0[1]); w.y = cvt_pk_bf16(v0[2], v0[3]); w.z = cvt_pk_bf16(v1[0], v1[1]); w.w = cvt_pk_bf16(v1[2], v1[3]);
                    *(u32x4*)(rowp + bj * 128) = w; } }
    }
};
struct EpiGlu {
    static constexpr bool PERM = true;
    const bf16_t* yg; bf16_t* mix; const float* bias;
    __device__ __forceinline__ void operator()(const AccT& acc, const Unit& u, int wr, int wc, int fr, int fq) const {
        const int col0 = u.pn * 256 + wc * 32 + 8 * fq;
#pragma unroll
        for (int ai = 0; ai < 2; ++ai)
#pragma unroll
            for (int m = 0; m < 4; ++m) { const size_t row = (size_t)(u.pm * 256 + ai * 128 + wr * 64 + m * 16 + fr);
#pragma unroll
                for (int bj = 0; bj < 2; ++bj) { const int c = col0 + bj * 128;
                    const f32x4 v0 = acc[ai][bj][m][0] + *(const f32x4*)(bias + c), v1 = acc[ai][bj][m][1] + *(const f32x4*)(bias + c + 4);
                    const u32x4 y = *(const u32x4*)(yg + row * 1024 + c);
                    u32x4 w;
                    w.x = cvt_pk_bf16(bflo(y.x) * sigmoidf_(v0[0]), bfhi(y.x) * sigmoidf_(v0[1]));
                    w.y = cvt_pk_bf16(bflo(y.y) * sigmoidf_(v0[2]), bfhi(y.y) * sigmoidf_(v0[3]));
                    w.z = cvt_pk_bf16(bflo(y.z) * sigmoidf_(v1[0]), bfhi(y.z) * sigmoidf_(v1[1]));
                    w.w = cvt_pk_bf16(bflo(y.w) * sigmoidf_(v1[2]), bfhi(y.w) * sigmoidf_(v1[3]));
                    *(u32x4*)(mix + row * 2048 + 1024 + c) = w; } }
    }
};
struct EpiResid {
    static constexpr bool PERM = false;
    const float* xp; const float* xs; float* xout; const float* gate;
    float* part;
    __device__ __forceinline__ void operator()(const AccT& acc, const Unit& u, int wr, int wc, int fr, int fq) const {
        const int colb = u.pn * 256 + wc * 32 + 4 * fq;
        if (u.ks >= 0) {
#pragma unroll
            for (int ai = 0; ai < 2; ++ai)
#pragma unroll
                for (int m = 0; m < 4; ++m) { bf16_t* pr = (bf16_t*)part + ((size_t)u.ks * 1024 + (size_t)((u.pm - 32) * 256 + ai * 128 + wr * 64 + m * 16 + fr)) * DM;
#pragma unroll
                    for (int bj = 0; bj < 2; ++bj)
#pragma unroll
                        for (int n = 0; n < 2; ++n) { const f32x4 v = acc[ai][bj][m][n]; u32x2 o = {cvt_pk_bf16(v[0], v[1]), cvt_pk_bf16(v[2], v[3])}; *(u32x2*)(pr + colb + bj * 128 + n * 16) = o; } }
            return;
        }
#pragma unroll
        for (int ai = 0; ai < 2; ++ai)
#pragma unroll
            for (int m = 0; m < 4; ++m) {
                const int row = u.pm * 256 + ai * 128 + wr * 64 + m * 16 + fr;
                const float* xr = row < NPROMPT ? xp + (size_t)row * DM : xs + (size_t)(row - NPROMPT) * DM;
                const float* gr = gate + (size_t)row_seq(row) * 24576;
#pragma unroll
                for (int bj = 0; bj < 2; ++bj)
#pragma unroll
                    for (int n = 0; n < 2; ++n) { const int c = colb + bj * 128 + n * 16;
                        *(f32x4*)(xout + (size_t)row * DM + c) = *(const f32x4*)(xr + c) + *(const f32x4*)(gr + c) * acc[ai][bj][m][n]; }
            }
    }
};
struct EpiUpPart {
    static constexpr bool PERM = true;
    bf16_t* upart;
    __device__ __forceinline__ void operator()(const AccT& acc, const Unit& u, int wr, int wc, int fr, int fq) const {
        const int tr = u.pm == 35 ? u.pn : 44 + (u.pn - 40);
        bf16_t* tb = upart + ((size_t)u.ks * 48 + tr) * 65536 + wc * 32 + 8 * fq;
#pragma unroll
        for (int ai = 0; ai < 2; ++ai)
#pragma unroll
            for (int m = 0; m < 4; ++m)
#pragma unroll
                for (int bj = 0; bj < 2; ++bj) { const f32x4 v0 = acc[ai][bj][m][0], v1 = acc[ai][bj][m][1];
                    u32x4 w4; w4.x = cvt_pk_bf16(v0[0], v0[1]); w4.y = cvt_pk_bf16(v0[2], v0[3]); w4.z = cvt_pk_bf16(v1[0], v1[1]); w4.w = cvt_pk_bf16(v1[2], v1[3]);
                    *(u32x4*)(tb + (size_t)(ai * 128 + wr * 64 + m * 16 + fr) * 256 + bj * 128) = w4; }
    }
};
struct EpiSwiglu {
    static constexpr bool PERM = true;
    bf16_t* hh;
    __device__ __forceinline__ void operator()(const AccT& acc, const Unit& u, int wr, int wc, int fr, int fq) const {
        const int col0 = u.pn * 128 + wc * 32 + 8 * fq;
#pragma unroll
        for (int ai = 0; ai < 2; ++ai)
#pragma unroll
            for (int m = 0; m < 4; ++m) { const size_t row = (size_t)(u.pm * 256 + ai * 128 + wr * 64 + m * 16 + fr);
                const f32x4 a0 = acc[ai][0][m][0], a1 = acc[ai][0][m][1], b0 = acc[ai][1][m][0], b1 = acc[ai][1][m][1];
                u32x4 w;
                w.x = cvt_pk_bf16(siluf_(a0[0]) * b0[0], siluf_(a0[1]) * b0[1]); w.y = cvt_pk_bf16(siluf_(a0[2]) * b0[2], siluf_(a0[3]) * b0[3]);
                w.z = cvt_pk_bf16(siluf_(a1[0]) * b1[0], siluf_(a1[1]) * b1[1]); w.w = cvt_pk_bf16(siluf_(a1[2]) * b1[2], siluf_(a1[3]) * b1[3]);
                *(u32x4*)(hh + row * DFF + col0) = w; }
    }
};

__device__ __forceinline__ void tr_item(LAS float* tile, const float* WA, const float* WB, int ldw, bf16_t* WT  , int K) {
    const int tid = threadIdx.x;
    const int col = tid & 255, rh = tid >> 8;
    const float* src = (col < 128 ? WA + col : WB + (col - 128)) + (size_t)rh * ldw;
    float v[32];
#pragma unroll
    for (int i = 0; i < 32; ++i) v[i] = src[(size_t)(2 * i) * ldw];
#pragma unroll
    for (int i = 0; i < 32; ++i) tile[(2 * i + rh) * 257 + col] = v[i];
    __syncthreads();
#pragma unroll
    for (int i = 0; i < 4; ++i) { const int c = tid + 512 * i, n = c >> 3, kc = c & 7; const LAS float* s = tile + (kc * 8) * 257 + n;
        u32x4 o; o.x = cvt_pk_bf16(s[0], s[257]); o.y = cvt_pk_bf16(s[2 * 257], s[3 * 257]); o.z = cvt_pk_bf16(s[4 * 257], s[5 * 257]); o.w = cvt_pk_bf16(s[6 * 257], s[7 * 257]);
        *(u32x4*)(WT + (size_t)n * K + kc * 8) = o; }
    __syncthreads();
}
constexpr int CONV_EARLY = 4 * 32 * 24 + 32 * 16;
constexpr int CONV_ALL = 4 * 32 * 24 + 32 * 16 + 16 * 4 + 32 * 8 + 2 * 32 * 44 + 2 * 88 * 8 + 32 * 24 + 32 * 8;
__device__ __forceinline__ void conv_items(LAS unsigned char* lds, const Params& P, int it0, int it1, int b, int G) {
    LAS float* tile = (LAS float*)lds;
    constexpr int N_ADA = 32 * 24, N_ABIN = 32 * 16, N_GLU = 16 * 4, N_SQ = 32 * 8, N_F13 = 32 * 44, N_F2 = 88 * 8, N_MLIN = 32 * 24;
    constexpr int NITEMS = 4 * N_ADA + N_ABIN + N_GLU + N_SQ + 2 * N_F13 + 2 * N_F2 + N_MLIN + N_SQ;
    static_assert(NITEMS == CONV_ALL, "item count");
    for (int it = it0 + b; it < it1; it += G) {
        int r = it;
        if (r < 4 * N_ADA) { const int a = r / N_ADA; r -= a * N_ADA; const int kt = r / 24, ntl = r % 24;
            const float* W = a == 0 ? P.in[I_ABADAW] : (a == 1 ? P.in[I_FADAW] : (a == 2 ? P.in[I_MLADAW] : P.in[I_FADAW] + (size_t)DM * 6144));
            const float* s = W + (size_t)(kt * 64) * 6144 + ntl * 256;
            tr_item(tile, s, s + 128, 6144, (bf16_t*)(P.ws + OFF_WADA) + (size_t)(a * 6144 + ntl * 256) * DM + kt * 64, DM); continue; }
        r -= 4 * N_ADA;
        if (r < N_ABIN) { const int kt = r / 16, ntl = r % 16; const int c0 = ntl * 256 + (ntl >= 12 ? 16 : 0);
            const float* s = P.in[I_ABWIN] + (size_t)(kt * 64) * 4112 + c0;
            tr_item(tile, s, s + 128, 4112, (bf16_t*)(P.ws + OFF_WABIN) + (size_t)(ntl * 256) * DM + kt * 64, DM); continue; }
        r -= N_ABIN;
        if (r < N_GLU) { const int kt = r / 4, ntl = r % 4; const float* s = P.in[I_S5WGLU] + (size_t)(kt * 64) * 1024 + ntl * 256;
            tr_item(tile, s, s + 128, 1024, (bf16_t*)(P.ws + OFF_WGLU) + (size_t)(ntl * 256) * 1024 + kt * 64, 1024); continue; }
        r -= N_GLU;
        if (r < N_SQ) { const int kt = r / 8, ntl = r % 8; const float* s = P.in[I_ABWOUT] + (size_t)(kt * 64) * DM + ntl * 256;
            tr_item(tile, s, s + 128, DM, (bf16_t*)(P.ws + OFF_WABOUT) + (size_t)(ntl * 256) * DM + kt * 64, DM); continue; }
        r -= N_SQ;
        if (r < 2 * N_F13) { const int l = r / N_F13; r -= l * N_F13; const int kt = r / 44, ntl = r % 44;
            const float* sa = P.in[I_FW1] + (size_t)l * DM * DFF + (size_t)(kt * 64) * DFF + ntl * 128;
            const float* sb = P.in[I_FW3] + (size_t)l * DM * DFF + (size_t)(kt * 64) * DFF + ntl * 128;
            tr_item(tile, sa, sb, DFF, (bf16_t*)(P.ws + OFF_WF13) + (size_t)l * 11264 * DM + (size_t)(ntl * 256) * DM + kt * 64, DM); continue; }
        r -= 2 * N_F13;
        if (r < 2 * N_F2) { const int l = r / N_F2; r -= l * N_F2; const int kt = r / 8, ntl = r % 8;
            const float* s = P.in[I_FW2] + (size_t)l * DFF * DM + (size_t)(kt * 64) * DM + ntl * 256;
            tr_item(tile, s, s + 128, DM, (bf16_t*)(P.ws + OFF_WF2) + (size_t)l * DM * DFF + (size_t)(ntl * 256) * DFF + kt * 64, DFF); continue; }
        r -= 2 * N_F2;
        if (r < N_MLIN) { const int kt = r / 24, ntl = r % 24; const float* s = P.in[I_MLWIN] + (size_t)(kt * 64) * 6152 + ntl * 256;
            tr_item(tile, s, s + 128, 6152, (bf16_t*)(P.ws + OFF_WMLIN) + (size_t)(ntl * 256) * DM + kt * 64, DM); continue; }
        r -= N_MLIN;
        { const int kt = r / 8, ntl = r % 8; const float* s = P.in[I_MLWOUT] + (size_t)(kt * 64) * DM + ntl * 256;
            tr_item(tile, s, s + 128, DM, (bf16_t*)(P.ws + OFF_WMLOUT) + (size_t)(ntl * 256) * DM + kt * 64, DM); }
    }
}
__device__ __forceinline__ void p0_prologue(LAS unsigned char* lds, const Params& P) {
    const int G = gridDim.x, b = blockIdx.x;
    conv_items(lds, P, 0, 768, b, G);
    const int gt = b * NTHREADS + threadIdx.x, GT = G * NTHREADS;
    bf16_t* cs = (bf16_t*)(P.ws + OFF_CS);
    for (int i = gt; i < 256 * DM; i += GT) { const int row = i >> 11, c = i & 2047; float v = 0.f;
        if (row < 4) v = siluf_(P.in[I_CP][row * DM + c]); else if (row < NSEQ) v = siluf_(P.in[I_CS][(row - 4) * DM + c]);
        cs[i] = f2bf(v); }
    float* wglr = (float*)(P.ws + OFF_WGLR);
    for (int i = gt; i < 16 * DM; i += GT) { const int r = i >> 11, k = i & 2047; wglr[i] = P.in[I_ABWIN][(size_t)k * 4112 + 3072 + r]; }
    float* bada = (float*)(P.ws + OFF_BADA);
    for (int i = gt; i < 24576; i += GT) { const int a = i / 6144, c = i - a * 6144;
        bada[i] = a == 0 ? P.in[I_ABADAB][c] : (a == 1 ? P.in[I_FADAB][c] : (a == 2 ? P.in[I_MLADAB][c] : P.in[I_FADAB][6144 + c])); }
    float* wmlg = (float*)(P.ws + OFF_WMLG);
    for (int i = gt; i < 8 * DM; i += GT) { const int r = i >> 11, k = i & 2047; wmlg[i] = P.in[I_MLWIN][(size_t)k * 6152 + 6144 + r]; }
}

template <int MODE>
__device__ __forceinline__ void norm_phase(LAS unsigned char* lds, const Params& P, const float* norm_g, int ada_idx, int fix_idx) {
    const int tid = threadIdx.x, lane = tid & 63, w = tid >> 6;
    LAS float* wl = (LAS float*)lds;
    if (MODE == 0) { const f32x4* s = (const f32x4*)(P.ws + OFF_WGLR); for (int i = tid; i < 16 * DM / 4; i += NTHREADS) ((LAS f32x4*)wl)[i] = s[i]; __syncthreads(); }
    if (MODE == 2) { const f32x4* s = (const f32x4*)(P.ws + OFF_WMLG); for (int i = tid; i < 8 * DM / 4; i += NTHREADS) ((LAS f32x4*)wl)[i] = s[i]; __syncthreads(); }
    const float* mod = (const float*)(P.ws + OFF_MOD);
    float* xcur = (float*)(P.ws + OFF_XCUR);
    bf16_t* hA = (bf16_t*)(P.ws + OFF_HA);
    for (int row = blockIdx.x * 8 + w; row < MROWS; row += gridDim.x * 8) {
        const float* xr = MODE == 0 ? (row < NPROMPT ? P.in[I_XP] + (size_t)row * DM : P.in[I_XS] + (size_t)(row - NPROMPT) * DM) : xcur + (size_t)row * DM;
        f32x4 v[8]; float ss = 0.f;
        if (MODE != 0 && fix_idx >= 0 && row >= NPROMPT && gridDim.x == 256) {
            const float* base = fix_idx == 0 ? P.in[I_XS] + (size_t)(row - NPROMPT) * DM : xr;
            const float* gr = mod + (size_t)row_seq(row) * 24576 + fix_idx * 6144 + 4096;
            const bf16_t* pr = (const bf16_t*)(P.ws + OFF_PART) + (size_t)(row - NPROMPT) * DM;
#pragma unroll
            for (int j = 0; j < 8; ++j) { f32x4 a = {0.f, 0.f, 0.f, 0.f};
#pragma unroll
                for (int ks = 0; ks < 8; ++ks) { const u32x2 pv = ((const u32x2*)(pr + (size_t)ks * 1024 * DM))[lane + 64 * j]; a[0] += bflo(pv.x); a[1] += bfhi(pv.x); a[2] += bflo(pv.y); a[3] += bfhi(pv.y); }
                v[j] = ((const f32x4*)base)[lane + 64 * j] + ((const f32x4*)gr)[lane + 64 * j] * a;
                ((f32x4*)(xcur + (size_t)row * DM))[lane + 64 * j] = v[j]; }
        } else {
#pragma unroll
            for (int j = 0; j < 8; ++j) v[j] = ((const f32x4*)xr)[lane + 64 * j];
        }
#pragma unroll
        for (int j = 0; j < 8; ++j) { ss += (v[j][0] * v[j][0] + v[j][1] * v[j][1]) + (v[j][2] * v[j][2] + v[j][3] * v[j][3]); }
        const float rstd = rsqrtf(wave_sum(ss) * (1.f / DM) + EPS);
        if (MODE == 3) {
            float* o = row < NPROMPT ? P.out + O_YP + (size_t)row * DM : P.out + O_YS + (size_t)(row - NPROMPT) * DM;
#pragma unroll
            for (int j = 0; j < 8; ++j) { const f32x4 g = ((const f32x4*)norm_g)[lane + 64 * j]; ((f32x4*)o)[lane + 64 * j] = v[j] * rstd * g; }
            continue;
        }
        const float* mr = mod + (size_t)row_seq(row) * 24576 + ada_idx * 6144;
#pragma unroll
        for (int j = 0; j < 8; ++j) { const f32x4 g = ((const f32x4*)norm_g)[lane + 64 * j], sh = ((const f32x4*)mr)[lane + 64 * j], sc = ((const f32x4*)(mr + DM))[lane + 64 * j];
            v[j] = v[j] * rstd * g * (sc + 1.f) + sh;
            u32x2 o; o.x = cvt_pk_bf16(v[j][0], v[j][1]); o.y = cvt_pk_bf16(v[j][2], v[j][3]);
            ((u32x2*)(hA + (size_t)row * DM))[lane + 64 * j] = o; }
        if (MODE == 0) {
            LAS float* GL = (LAS float*)(lds + 131072) + w * 16;
#pragma unroll 1
            for (int r = 0; r < 16; ++r) { float a = 0.f;
#pragma unroll
                for (int j = 0; j < 8; ++j) { const f32x4 ww = ((const LAS f32x4*)(wl + r * DM))[lane + 64 * j]; a += (v[j][0] * ww[0] + v[j][1] * ww[1]) + (v[j][2] * ww[2] + v[j][3] * ww[3]); }
                a = wave_sum(a); if (lane == 0) GL[r] = a; }
            LDS_FENCE();
            float g[16];
#pragma unroll
            for (int r = 0; r < 16; ++r) g[r] = GL[r];
            float* la = (float*)(P.ws + OFF_LA) + (size_t)row * 512;
#pragma unroll 2
            for (int i = 0; i < 8; ++i) { const int n = lane + 64 * i; float a = P.in[I_GLABG][n];
#pragma unroll
                for (int r = 0; r < 16; ++r) a += g[r] * P.in[I_GLAWG][r * 512 + n];
                la[n] = logsigmoidf_(a) * (1.f / 16.f); }
            LDS_FENCE();
        }
        if (MODE == 2) {
            float g[8];
#pragma unroll
            for (int r = 0; r < 8; ++r) { float a = 0.f;
#pragma unroll
                for (int j = 0; j < 8; ++j) { const f32x4 ww = ((const LAS f32x4*)(wl + r * DM))[lane + 64 * j]; a += (v[j][0] * ww[0] + v[j][1] * ww[1]) + (v[j][2] * ww[2] + v[j][3] * ww[3]); }
                g[r] = wave_sum(a); }
            if (lane < 8) { float val = 0.f;
#pragma unroll
                for (int r = 0; r < 8; ++r) if (lane == r) val = g[r];
                val = lane < 4 ? val + P.in[I_MLBI][lane] : logsigmoidf_(val + P.in[I_MLBF][lane - 4]);
                ((float*)(P.ws + OFF_GT))[(size_t)row * 8 + lane] = val; }
        }
    }
    if (MODE == 0 || MODE == 2) __syncthreads();
}

template <int L>
__device__ __forceinline__ void gla_unit(LAS unsigned char* lds, const Params& P, int head, int vs, int row0, int nchunks, int nvalid, const float* s_in, float* s_out) {
    constexpr int TPT = L / 4, NTT = L / 16, NKS = L / 32, LP = L + 8, QP = 136;
    LAS bf16_t* QE = (LAS bf16_t*)lds;
    LAS bf16_t* KE = QE + L * QP;
    LAS bf16_t* K2T = KE + L * QP;
    LAS bf16_t* VT = K2T + 128 * LP;
    LAS bf16_t* ATT = VT + 128 * LP;
    LAS float* QS = (LAS float*)(ATT + L * LP);
    LAS float* DEC = QS + 512;
    const int tid = threadIdx.x, lane = tid & 63, w = tid >> 6, quad = lane >> 4, l16 = lane & 15;
    const int d = tid & 127, tq = tid >> 7;
    const bf16_t* z = (const bf16_t*)(P.ws + OFF_Z);
    const float* la = (const float*)(P.ws + OFF_LA);
    float* obuf = (float*)(P.ws + OFF_OBUF);
    const int vcol = vs * 128 + w * 16;
    const float scale = 0.08838834764831845f;
    float lav[TPT]; unsigned qv[TPT], kv[TPT], vv[TPT];
#define GLA_LOAD(rr) do { _Pragma("unroll") for (int i = 0; i < TPT; ++i) { const int t = tq * TPT + i; lav[i] = 0.f; qv[i] = 0; kv[i] = 0; vv[i] = 0; \
            if (t < nvalid) { lav[i] = la[(size_t)((rr) + t) * 512 + head * 128 + d]; const bf16_t* zr = z + (size_t)((rr) + t) * 4096; \
                qv[i] = zr[head * 128 + d]; kv[i] = zr[512 + head * 128 + d]; vv[i] = zr[1024 + head * 256 + vs * 128 + d]; } } } while (0)
    GLA_LOAD(row0);
    f32x4 S[8];
#pragma unroll
    for (int dt = 0; dt < 8; ++dt) {
        if (s_in) {
#pragma unroll
            for (int j = 0; j < 4; ++j) S[dt][j] = s_in[(size_t)(dt * 16 + quad * 4 + j) * 256 + vcol + l16];
        } else S[dt] = (f32x4){0.f, 0.f, 0.f, 0.f};
    }
    for (int c = 0; c < nchunks; ++c) {
        const int r0 = row0 + c * L;
        float b[TPT]; float run = 0.f;
#pragma unroll
        for (int i = 0; i < TPT; ++i) { run += lav[i]; b[i] = run; }
        QS[tq * 128 + d] = run;
        __syncthreads();
        float pre = 0.f, tot = 0.f;
#pragma unroll
        for (int q = 0; q < 4; ++q) { const float x = QS[q * 128 + d]; tot += x; if (q < tq) pre += x; }
        unsigned k2[TPT]; const float etot = __expf(tot);
#pragma unroll
        for (int i = 0; i < TPT; ++i) { const int t = tq * TPT + i; const float bb = b[i] + pre; const float q = bf2f(qv[i]), k = bf2f(kv[i]); const float kem = k * __expf(-bb);
            QE[t * QP + d] = f2bf(q * scale * __expf(bb)); KE[t * QP + d] = f2bf(kem); k2[i] = f2bf(kem * etot); }
#pragma unroll
        for (int i = 0; i < TPT; i += 8) {
            u32x4 o = {k2[i] | (k2[i + 1] << 16), k2[i + 2] | (k2[i + 3] << 16), k2[i + 4] | (k2[i + 5] << 16), k2[i + 6] | (k2[i + 7] << 16)};
            *(LAS u32x4*)(K2T + d * LP + tq * TPT + i) = o;
            u32x4 o2 = {vv[i] | (vv[i + 1] << 16), vv[i + 2] | (vv[i + 3] << 16), vv[i + 4] | (vv[i + 5] << 16), vv[i + 6] | (vv[i + 7] << 16)};
            *(LAS u32x4*)(VT + d * LP + tq * TPT + i) = o2; }
        if (c + 1 < nchunks) GLA_LOAD(r0 + L);
        if (tq == 0) DEC[d] = etot;
        __syncthreads();
        constexpr int NTASK = NTT == 4 ? 12 : 4;
        for (int idx = w; idx < NTASK; idx += 8) {
            int tt, st; if (NTT == 4) { if (idx < 2) { tt = 0; st = idx; } else if (idx < 4) { tt = 1; st = idx - 2; } else if (idx < 8) { tt = 2; st = idx - 4; } else { tt = 3; st = idx - 8; } } else { tt = idx >> 1; st = idx & 1; }
            f32x4 acc = {0.f, 0.f, 0.f, 0.f};
            if (st <= tt) {
#pragma unroll
                for (int ks = 0; ks < 4; ++ks) { const bf16x8 A = *(const LAS bf16x8*)(KE + (st * 16 + l16) * QP + ks * 32 + quad * 8), B = *(const LAS bf16x8*)(QE + (tt * 16 + l16) * QP + ks * 32 + quad * 8);
                    acc = MFMA16(A, B, acc); }
                const int t = tt * 16 + l16;
#pragma unroll
                for (int j = 0; j < 4; ++j) if (st * 16 + quad * 4 + j > t) acc[j] = 0.f;
            }
            u32x2 o = {cvt_pk_bf16(acc[0], acc[1]), cvt_pk_bf16(acc[2], acc[3])};
            *(LAS u32x2*)(ATT + (tt * 16 + l16) * LP + st * 16 + quad * 4) = o;
        }
        __syncthreads();
        bf16x8 sa[4];
#pragma unroll
        for (int ks = 0; ks < 4; ++ks) sa[ks] = mk8(cvt_pk_bf16(S[2 * ks][0], S[2 * ks][1]), cvt_pk_bf16(S[2 * ks][2], S[2 * ks][3]), cvt_pk_bf16(S[2 * ks + 1][0], S[2 * ks + 1][1]), cvt_pk_bf16(S[2 * ks + 1][2], S[2 * ks + 1][3]));
#pragma unroll
        for (int tt = 0; tt < NTT; ++tt) {
            const int t = tt * 16 + l16; f32x4 acc = {0.f, 0.f, 0.f, 0.f};
#pragma unroll
            for (int ks = 0; ks < 4; ++ks) { const u32x2 lo = *(const LAS u32x2*)(QE + t * QP + ks * 32 + quad * 4), hi = *(const LAS u32x2*)(QE + t * QP + ks * 32 + 16 + quad * 4);
                acc = MFMA16(sa[ks], mk8(lo.x, lo.y, hi.x, hi.y), acc); }
#pragma unroll
            for (int k2s = 0; k2s < NKS; ++k2s) if (2 * k2s <= tt) { const bf16x8 A = *(const LAS bf16x8*)(VT + (w * 16 + l16) * LP + k2s * 32 + quad * 8), B = *(const LAS bf16x8*)(ATT + t * LP + k2s * 32 + quad * 8);
                acc = MFMA16(A, B, acc); }
            if (t < nvalid) *(f32x4*)(obuf + (size_t)(r0 + t) * 2048 + head * 256 + vcol + quad * 4) = acc;
        }
#pragma unroll
        for (int dt = 0; dt < 8; ++dt) { const f32x4 dc = *(const LAS f32x4*)(DEC + dt * 16 + quad * 4); f32x4 acc = S[dt] * dc;
#pragma unroll
            for (int k2s = 0; k2s < NKS; ++k2s) { const bf16x8 A = *(const LAS bf16x8*)(K2T + (dt * 16 + l16) * LP + k2s * 32 + quad * 8), B = *(const LAS bf16x8*)(VT + (w * 16 + l16) * LP + k2s * 32 + quad * 8);
                acc = MFMA16(A, B, acc); }
            S[dt] = acc; }
        __syncthreads();
    }
#pragma unroll
    for (int dt = 0; dt < 8; ++dt)
#pragma unroll
        for (int j = 0; j < 4; ++j) s_out[(size_t)(dt * 16 + quad * 4 + j) * 256 + vcol + l16] = S[dt][j];
}

__device__ __forceinline__ void s5_wave(LAS unsigned char* wl, const Params& P, int g, int row0_, int nblocks, int nvalid, const float* h0re_, const float* h0im_, float* ore_, float* oim_, int nseq = 1, int rstride = 0, int sstride = 0) {
    LAS float* BU = (LAS float*)wl;
    LAS bf16_t* HS = (LAS bf16_t*)(wl + 8448);
    const int lane = threadIdx.x & 63, quad = lane >> 4, l16 = lane & 15;
    const float dt = __expf(P.in[I_S5LDT][g]);
    float a_re, a_im;
    { const float lr = P.in[I_S5LRE][g * 64 + lane], li = P.in[I_S5LIM][g * 64 + lane]; const float mag = expf(lr * dt); float sn, cn; sincosf(li * dt, &sn, &cn); a_re = mag * cn; a_im = mag * sn; }
    bf16x8 bfr[8];
#pragma unroll
    for (int nt = 0; nt < 8; ++nt) {
        const int p = nt * 8 + (l16 >> 1); const bool isim = (l16 & 1) != 0;
        const float lr = P.in[I_S5LRE][g * 64 + p], li = P.in[I_S5LIM][g * 64 + p]; const float mag = expf(lr * dt); float sn, cn; sincosf(li * dt, &sn, &cn);
        const float ar = mag * cn, ai = mag * sn, den = lr * lr + li * li;
        const float fr = ((ar - 1.f) * lr + ai * li) / den, fi = (ai * lr - (ar - 1.f) * li) / den;
        unsigned pk[4] = {0, 0, 0, 0};
        if (quad < 2) {
            const float* br = P.in[I_S5BRE] + (size_t)(g * 64 + p) * 16 + quad * 8; const float* bi = P.in[I_S5BIM] + (size_t)(g * 64 + p) * 16 + quad * 8;
#pragma unroll
            for (int j = 0; j < 4; ++j) { const float r0 = br[2 * j], r1 = br[2 * j + 1], i0 = bi[2 * j], i1 = bi[2 * j + 1];
                pk[j] = isim ? cvt_pk_bf16(fr * i0 + fi * r0, fr * i1 + fi * r1) : cvt_pk_bf16(fr * r0 - fi * i0, fr * r1 - fi * i1); }
        }
        bfr[nt] = mk8(pk[0], pk[1], pk[2], pk[3]);
    }
    bf16x8 cfr[4];
#pragma unroll
    for (int ks = 0; ks < 4; ++ks) { const int p0 = ks * 16 + quad * 4; const float* cr = P.in[I_S5CRE] + (size_t)(g * 16 + l16) * 64 + p0; const float* ci = P.in[I_S5CIM] + (size_t)(g * 16 + l16) * 64 + p0;
        cfr[ks] = mk8(cvt_pk_bf16(cr[0], -ci[0]), cvt_pk_bf16(cr[1], -ci[1]), cvt_pk_bf16(cr[2], -ci[2]), cvt_pk_bf16(cr[3], -ci[3])); }
    const float dsk = P.in[I_S5D][g * 16 + l16];
    const bf16_t* z = (const bf16_t*)(P.ws + OFF_Z);
    bf16_t* yg = (bf16_t*)(P.ws + OFF_YG);
    for (int si = 0; si < nseq; ++si) {
    const int row0 = row0_ + si * rstride; float* ore = ore_ + (size_t)si * sstride; float* oim = oim_ + (size_t)si * sstride;
    float hr = h0re_ ? h0re_[(size_t)si * sstride + lane] : 0.f, hi = h0im_ ? h0im_[(size_t)si * sstride + lane] : 0.f;
    bf16x8 Aq[4]; unsigned uq[4][4];
#define S5_LOADG(b0) do { _Pragma("unroll") for (int q = 0; q < 4; ++q) if ((b0) + q < nblocks) { const int rr = row0 + ((b0) + q) * 16; \
            Aq[q] = mk8(0, 0, 0, 0); if (quad < 2 && l16 < nvalid) Aq[q] = *(const bf16x8*)(z + (size_t)(rr + l16) * 4096 + 3072 + g * 16 + quad * 8); \
            _Pragma("unroll") for (int j = 0; j < 4; ++j) uq[q][j] = (quad * 4 + j < nvalid) ? (unsigned)z[(size_t)(rr + quad * 4 + j) * 4096 + 3072 + g * 16 + l16] : 0u; } } while (0)
    S5_LOADG(0);
    for (int blk0 = 0; blk0 < nblocks; blk0 += 4) {
        bf16x8 Ac[4]; unsigned uc[4][4];
#pragma unroll
        for (int q = 0; q < 4; ++q) { Ac[q] = Aq[q];
#pragma unroll
            for (int j = 0; j < 4; ++j) uc[q][j] = uq[q][j]; }
        if (blk0 + 4 < nblocks) S5_LOADG(blk0 + 4);
#pragma unroll
        for (int q = 0; q < 4; ++q) if (blk0 + q < nblocks) {
            const int r0 = row0 + (blk0 + q) * 16;
#pragma unroll
            for (int nt = 0; nt < 8; ++nt) { const f32x4 dd = MFMA16(Ac[q], bfr[nt], ((f32x4){0.f, 0.f, 0.f, 0.f}));
#pragma unroll
                for (int j = 0; j < 4; ++j) BU[(quad * 4 + j) * 132 + nt * 16 + l16] = dd[j]; }
            LDS_FENCE();
#pragma unroll
            for (int t = 0; t < 16; ++t) if (t < nvalid) { const f32x2 bb = *(const LAS f32x2*)(BU + t * 132 + 2 * lane);
                const float nr = a_re * hr - a_im * hi + bb[0], ni = a_re * hi + a_im * hr + bb[1]; hr = nr; hi = ni;
                *(LAS unsigned*)(HS + t * 136 + 2 * lane) = cvt_pk_bf16(hr, hi); }
            LDS_FENCE();
            f32x4 acc = {0.f, 0.f, 0.f, 0.f};
#pragma unroll
            for (int ks = 0; ks < 4; ++ks) { const bf16x8 Ah = *(const LAS bf16x8*)(HS + l16 * 136 + ks * 32 + quad * 8); acc = MFMA16(Ah, cfr[ks], acc); }
#pragma unroll
            for (int j = 0; j < 4; ++j) if (quad * 4 + j < nvalid) { const float y = acc[j] + dsk * bf2f(uc[q][j]); yg[(size_t)(r0 + quad * 4 + j) * 1024 + g * 16 + l16] = f2bf(gelu_tanh(y)); }
            LDS_FENCE();
        }
    }
    ore[lane] = hr; oim[lane] = hi;
    }
#undef S5_LOADG
}

template <int L>
__device__ __forceinline__ void ml_unit(LAS unsigned char* lds, const Params& P, int head, int vs, int row0, int nchunks, int nvalid,
                                        const float* c_in, const float* n_in, float m0, float* c_out, float* n_out, float* m_out) {
    constexpr int NTT = L / 16, NKS = L / 32, LP = L + 8, QP = 264, VQ = L / 4;
    LAS bf16_t* Q = (LAS bf16_t*)lds;
    LAS bf16_t* Kt = Q + L * QP;
    LAS bf16_t* KTS = Kt + L * QP;
    LAS bf16_t* VT = KTS + 256 * LP;
    LAS bf16_t* SW = VT + 128 * LP;
    LAS float* TB = (LAS float*)(SW + L * LP);
    LAS float* T_BTT = TB, *T_CS = TB + 64, *T_WS = TB + 128, *T_GI = TB + 192, *T_EMT = TB + 256, *T_NQ = TB + 320, *T_RS = TB + 384  , *T_N = TB + 640  ;
    const int tid = threadIdx.x, lane = tid & 63, w = tid >> 6, quad = lane >> 4, l16 = lane & 15;
    const bf16_t* z = (const bf16_t*)(P.ws + OFF_Z);
    const float* gt = (const float*)(P.ws + OFF_GT);
    float* obuf = (float*)(P.ws + OFF_OBUF);
    const int vcol = vs * 128 + w * 16;
    float nreg = 0.f; if (tid < 256) { nreg = n_in ? n_in[tid] : 0.f; T_N[tid] = nreg; }
    float m = m0;
    const int d2 = (tid & 127) * 2, tq = tid >> 7, vv_ = tid & 127;
    unsigned qv[VQ], kv[VQ], vv[VQ]; float fgn, ign;
#define ML_LOAD(rr) do { fgn = 0.f; ign = -1e30f; if (lane < L && lane < nvalid) { ign = gt[(size_t)((rr) + lane) * 8 + head]; fgn = gt[(size_t)((rr) + lane) * 8 + 4 + head]; } \
        _Pragma("unroll") for (int i = 0; i < VQ; ++i) { const int t = tq * VQ + i; qv[i] = 0; kv[i] = 0; vv[i] = 0; \
            if (t < nvalid) { const bf16_t* zr = z + (size_t)((rr) + t) * 6144; qv[i] = *(const unsigned*)(zr + head * 256 + d2); kv[i] = *(const unsigned*)(zr + 1024 + head * 256 + d2); \
                vv[i] = zr[2048 + head * 512 + vs * 128 + vv_]; } } } while (0)
    ML_LOAD(row0);
    f32x4 C[16];
#pragma unroll
    for (int dt = 0; dt < 16; ++dt) {
        if (c_in) C[dt] = *(const f32x4*)(c_in + (size_t)(vcol + l16) * 256 + dt * 16 + quad * 4);
        else C[dt] = (f32x4){0.f, 0.f, 0.f, 0.f};
    }
    for (int c = 0; c < nchunks; ++c) {
        const int r0 = row0 + c * L;
        const float fg = fgn, ig = ign;
        float bcum = fg;
#pragma unroll
        for (int o = 1; o < 64; o <<= 1) { const float x = __shfl_up(bcum, o); if (lane >= o) bcum += x; }
        const float csv = ig - bcum; float pm = csv;
#pragma unroll
        for (int o = 1; o < 64; o <<= 1) { const float x = __shfl_up(pm, o); if (lane >= o) pm = fmaxf(pm, x); }
        const float blast = __shfl(bcum, L - 1), pmall = __shfl(pm, L - 1);
        const float mx = fmaxf(m, pm), mxall = fmaxf(m, pmall);
        const float decay = __expf(m - mxall);
        if (w == 0 && lane < L) { T_BTT[lane] = -mx; T_CS[lane] = csv; T_WS[lane] = __expf(csv - mxall); T_GI[lane] = __expf(m - mx); T_EMT[lane] = __expf(-(bcum + mx)); }
        m = blast + mxall;
        __syncthreads();
#pragma unroll
        for (int i = 0; i < VQ; i += 8) {
            unsigned k0[8], k1[8];
#pragma unroll
            for (int e = 0; e < 8; ++e) { const int t = tq * VQ + i + e; const float ka = bflo(kv[i + e]) * 0.0625f, kb = bfhi(kv[i + e]) * 0.0625f; const float wsv = T_WS[t];
                *(LAS unsigned*)(Q + t * QP + d2) = qv[i + e]; *(LAS unsigned*)(Kt + t * QP + d2) = cvt_pk_bf16(ka, kb); k0[e] = f2bf(ka * wsv); k1[e] = f2bf(kb * wsv); }
            u32x4 o0 = {k0[0] | (k0[1] << 16), k0[2] | (k0[3] << 16), k0[4] | (k0[5] << 16), k0[6] | (k0[7] << 16)};
            u32x4 o1 = {k1[0] | (k1[1] << 16), k1[2] | (k1[3] << 16), k1[4] | (k1[5] << 16), k1[6] | (k1[7] << 16)};
            *(LAS u32x4*)(KTS + d2 * LP + tq * VQ + i) = o0; *(LAS u32x4*)(KTS + (d2 + 1) * LP + tq * VQ + i) = o1;
            u32x4 o = {vv[i] | (vv[i + 1] << 16), vv[i + 2] | (vv[i + 3] << 16), vv[i + 4] | (vv[i + 5] << 16), vv[i + 6] | (vv[i + 7] << 16)};
            *(LAS u32x4*)(VT + vv_ * LP + tq * VQ + i) = o; }
        if (c + 1 < nchunks) ML_LOAD(r0 + L);
        __syncthreads();
        { constexpr int PARTS = 512 / L, DPER = 256 / PARTS; const int t = tid / PARTS, part = tid % PARTS; float a = 0.f;
#pragma unroll 8
          for (int e = 0; e < DPER; ++e) a += T_N[part * DPER + e] * bf2f(Q[t * QP + part * DPER + e]);
#pragma unroll
          for (int o = 1; o < PARTS; o <<= 1) a += __shfl_xor(a, o);
          if (part == 0) T_NQ[t] = a; }
        constexpr int NTASK = NTT == 4 ? 12 : 4;
        for (int idx = w; idx < NTASK; idx += 8) {
            int tt, st; if (NTT == 4) { if (idx < 2) { tt = 0; st = idx; } else if (idx < 4) { tt = 1; st = idx - 2; } else if (idx < 8) { tt = 2; st = idx - 4; } else { tt = 3; st = idx - 8; } } else { tt = idx >> 1; st = idx & 1; }
            f32x4 acc = {0.f, 0.f, 0.f, 0.f}; const int t = tt * 16 + l16;
            if (st <= tt) {
#pragma unroll
                for (int ks = 0; ks < 8; ++ks) { const bf16x8 A = *(const LAS bf16x8*)(Kt + (st * 16 + l16) * QP + ks * 32 + quad * 8), B = *(const LAS bf16x8*)(Q + t * QP + ks * 32 + quad * 8);
                    acc = MFMA16(A, B, acc); }
                const float btt = T_BTT[t]; const f32x4 cs4 = *(const LAS f32x4*)(T_CS + st * 16 + quad * 4);
#pragma unroll
                for (int j = 0; j < 4; ++j) acc[j] = (st * 16 + quad * 4 + j > t) ? 0.f : acc[j] * __expf(btt + cs4[j]);
                float rs = (acc[0] + acc[1]) + (acc[2] + acc[3]); rs += __shfl_xor(rs, 16); rs += __shfl_xor(rs, 32);
                if (quad == 0) T_RS[t * 4 + st] = rs;
            }
            u32x2 o = {cvt_pk_bf16(acc[0], acc[1]), cvt_pk_bf16(acc[2], acc[3])};
            *(LAS u32x2*)(SW + t * LP + st * 16 + quad * 4) = o;
        }
        __syncthreads();
#pragma unroll
        for (int tt = 0; tt < NTT; ++tt) {
            const int t = tt * 16 + l16; f32x4 acc = {0.f, 0.f, 0.f, 0.f};
#pragma unroll
            for (int ks = 0; ks < 8; ++ks) {
                const bf16x8 sa = mk8(cvt_pk_bf16(C[2 * ks][0], C[2 * ks][1]), cvt_pk_bf16(C[2 * ks][2], C[2 * ks][3]), cvt_pk_bf16(C[2 * ks + 1][0], C[2 * ks + 1][1]), cvt_pk_bf16(C[2 * ks + 1][2], C[2 * ks + 1][3]));
                const u32x2 lo = *(const LAS u32x2*)(Q + t * QP + ks * 32 + quad * 4), hi = *(const LAS u32x2*)(Q + t * QP + ks * 32 + 16 + quad * 4);
                acc = MFMA16(sa, mk8(lo.x, lo.y, hi.x, hi.y), acc); }
            const float gi = T_GI[t]; acc = acc * gi;
#pragma unroll
            for (int k2s = 0; k2s < NKS; ++k2s) if (2 * k2s <= tt) { const bf16x8 A = *(const LAS bf16x8*)(VT + (w * 16 + l16) * LP + k2s * 32 + quad * 8), B = *(const LAS bf16x8*)(SW + t * LP + k2s * 32 + quad * 8);
                acc = MFMA16(A, B, acc); }
            float den = gi * T_NQ[t];
#pragma unroll
            for (int st = 0; st < NTT; ++st) if (st <= tt) den += T_RS[t * 4 + st];
            const float rd = 1.f / fmaxf(fabsf(den), T_EMT[t]);
            if (t < nvalid) *(f32x4*)(obuf + (size_t)(r0 + t) * 2048 + head * 512 + vcol + quad * 4) = acc * rd;
        }
#pragma unroll
        for (int dt = 0; dt < 16; ++dt) { f32x4 acc = C[dt] * decay;
#pragma unroll
            for (int k2s = 0; k2s < NKS; ++k2s) { const bf16x8 A = *(const LAS bf16x8*)(KTS + (dt * 16 + l16) * LP + k2s * 32 + quad * 8), B = *(const LAS bf16x8*)(VT + (w * 16 + l16) * LP + k2s * 32 + quad * 8);
                acc = MFMA16(A, B, acc); }
            C[dt] = acc; }
        if (tid < 256) { float a = nreg * decay;
#pragma unroll 8
            for (int s = 0; s < L; ++s) a += T_WS[s] * bf2f(Kt[s * QP + tid]);
            nreg = a; }
        __syncthreads();
        if (tid < 256) T_N[tid] = nreg;
    }
#pragma unroll
    for (int dt = 0; dt < 16; ++dt) *(f32x4*)(c_out + (size_t)(vcol + l16) * 256 + dt * 16 + quad * 4) = C[dt];
    if (vs == 0) { if (tid < 256) n_out[tid] = nreg; if (tid == 0) *m_out = m; }
    __syncthreads();
}


constexpr size_t MLB_STRIDE = 122880;
constexpr int MLB_KTS = 0, MLB_SW = 36864, MLB_VT = 46080, MLB_SC = 119808;
__device__ __forceinline__ unsigned char* ml_blob(const Params& P, int seq, int head, int c) { return P.ws + OFF_HH + (size_t)((seq * 4 + head) * 32 + c) * MLB_STRIDE; }

__device__ __forceinline__ void ml_prep(LAS unsigned char* lds, const Params& P, int seq, int head, int c) {
    constexpr int L = 64, QP = 264, LP = 72;
    LAS bf16_t* Q = (LAS bf16_t*)lds;
    LAS bf16_t* Kt = Q + L * QP;
    LAS float* TB = (LAS float*)(Kt + L * QP);
    LAS float* T_PM = TB, *T_CS = TB + 64, *T_RS = TB + 128, *T_KS = TB + 384;
    const int tid = threadIdx.x, lane = tid & 63, w = tid >> 6, quad = lane >> 4, l16 = lane & 15;
    const bf16_t* z = (const bf16_t*)(P.ws + OFF_Z);
    const float* gt = (const float*)(P.ws + OFF_GT);
    const int r0 = seq * 2048 + c * L;
    unsigned char* blob = ml_blob(P, seq, head, c);
    bf16_t* KTSg = (bf16_t*)(blob + MLB_KTS); bf16_t* SWg = (bf16_t*)(blob + MLB_SW); bf16_t* VTg = (bf16_t*)(blob + MLB_VT); float* SCg = (float*)(blob + MLB_SC);
    const float ig = gt[(size_t)(r0 + lane) * 8 + head], fg = gt[(size_t)(r0 + lane) * 8 + 4 + head];
    float bcum = fg;
#pragma unroll
    for (int o = 1; o < 64; o <<= 1) { const float x = __shfl_up(bcum, o); if (lane >= o) bcum += x; }
    const float csv = ig - bcum; float pm = csv;
#pragma unroll
    for (int o = 1; o < 64; o <<= 1) { const float x = __shfl_up(pm, o); if (lane >= o) pm = fmaxf(pm, x); }
    const float blast = __shfl(bcum, 63), pmall = __shfl(pm, 63);
    if (w == 0) { T_PM[lane] = pm; T_CS[lane] = csv; SCg[lane] = pm; SCg[64 + lane] = bcum; if (lane == 0) { SCg[448] = pmall; SCg[449] = blast; } }
    const int d2 = (tid & 127) * 2, tq = tid >> 7, vv_ = tid & 127;
    unsigned qv[16], kv[16];
#pragma unroll
    for (int i = 0; i < 16; ++i) { const bf16_t* zr = z + (size_t)(r0 + tq * 16 + i) * 6144; qv[i] = *(const unsigned*)(zr + head * 256 + d2); kv[i] = *(const unsigned*)(zr + 1024 + head * 256 + d2); }
    unsigned vvb[2][16];
#define MLP_VLOAD(buf, vsl_) do { _Pragma("unroll") for (int i = 0; i < 16; ++i) vvb[buf][i] = z[(size_t)(r0 + tq * 16 + i) * 6144 + 2048 + head * 512 + (vsl_) * 128 + vv_]; } while (0)
    MLP_VLOAD(0, 0);
#pragma unroll
    for (int vsl = 0; vsl < 4; ++vsl) {
        if (vsl + 1 < 4) MLP_VLOAD((vsl + 1) & 1, vsl + 1);
#pragma unroll
        for (int i = 0; i < 16; i += 8) { const unsigned* vv = vvb[vsl & 1];
            u32x4 o = {vv[i] | (vv[i + 1] << 16), vv[i + 2] | (vv[i + 3] << 16), vv[i + 4] | (vv[i + 5] << 16), vv[i + 6] | (vv[i + 7] << 16)};
            *(u32x4*)(VTg + (size_t)(vsl * 128 + vv_) * LP + tq * 16 + i) = o; } }
#undef MLP_VLOAD
    float s0 = 0.f, s1 = 0.f;
#pragma unroll
    for (int i = 0; i < 16; i += 8) {
        unsigned k0[8], k1[8];
#pragma unroll
        for (int e = 0; e < 8; ++e) { const int t = tq * 16 + i + e; const float ka = bflo(kv[i + e]) * 0.0625f, kb = bfhi(kv[i + e]) * 0.0625f; const float wsv = __expf(__shfl(csv, t) - pmall);
            *(LAS unsigned*)(Q + t * QP + d2) = qv[i + e]; *(LAS unsigned*)(Kt + t * QP + d2) = cvt_pk_bf16(ka, kb); k0[e] = f2bf(ka * wsv); k1[e] = f2bf(kb * wsv); s0 += ka * wsv; s1 += kb * wsv; }
        u32x4 o0 = {k0[0] | (k0[1] << 16), k0[2] | (k0[3] << 16), k0[4] | (k0[5] << 16), k0[6] | (k0[7] << 16)};
        u32x4 o1 = {k1[0] | (k1[1] << 16), k1[2] | (k1[3] << 16), k1[4] | (k1[5] << 16), k1[6] | (k1[7] << 16)};
        *(u32x4*)(KTSg + (size_t)d2 * LP + tq * 16 + i) = o0; *(u32x4*)(KTSg + (size_t)(d2 + 1) * LP + tq * 16 + i) = o1; }
    T_KS[tq * 256 + d2] = s0; T_KS[tq * 256 + d2 + 1] = s1;
    __syncthreads();
    if (tid < 256) SCg[192 + tid] = (T_KS[tid] + T_KS[256 + tid]) + (T_KS[512 + tid] + T_KS[768 + tid]);
    for (int idx = w; idx < 12; idx += 8) {
        int tt, st; if (idx < 2) { tt = 0; st = idx; } else if (idx < 4) { tt = 1; st = idx - 2; } else if (idx < 8) { tt = 2; st = idx - 4; } else { tt = 3; st = idx - 8; }
        f32x4 acc = {0.f, 0.f, 0.f, 0.f}; const int t = tt * 16 + l16;
        if (st <= tt) {
#pragma unroll
            for (int ks = 0; ks < 8; ++ks) { const bf16x8 A = *(const LAS bf16x8*)(Kt + (st * 16 + l16) * QP + ks * 32 + quad * 8), B = *(const LAS bf16x8*)(Q + t * QP + ks * 32 + quad * 8);
                acc = MFMA16(A, B, acc); }
            const float pmt = T_PM[t]; const f32x4 cs4 = *(const LAS f32x4*)(T_CS + st * 16 + quad * 4);
#pragma unroll
            for (int j = 0; j < 4; ++j) acc[j] = (st * 16 + quad * 4 + j > t) ? 0.f : acc[j] * __expf(cs4[j] - pmt);
            float rs = (acc[0] + acc[1]) + (acc[2] + acc[3]); rs += __shfl_xor(rs, 16); rs += __shfl_xor(rs, 32);
            if (quad == 0) T_RS[t * 4 + st] = rs;
        }
        u32x2 o = {cvt_pk_bf16(acc[0], acc[1]), cvt_pk_bf16(acc[2], acc[3])};
        *(u32x2*)(SWg + (size_t)t * LP + st * 16 + quad * 4) = o;
    }
    __syncthreads();
    if (tid < 64) { const int tt = tid >> 4; float rs = 0.f;
#pragma unroll
        for (int st = 0; st < 4; ++st) if (st <= tt) rs += T_RS[tid * 4 + st];
        SCg[128 + tid] = rs; }
    __syncthreads();
}

__device__ __forceinline__ void ml_chain(LAS unsigned char* lds, const Params& P, int seq, int head, int vs, float* c_out, float* n_out, float* m_out) {
    constexpr int QP = 264, LP = 72;
    LAS bf16_t* KTS = (LAS bf16_t*)lds;
    LAS bf16_t* SW = (LAS bf16_t*)(lds + 36864);
    LAS bf16_t* VT = (LAS bf16_t*)(lds + 46080);
    LAS float* SC = (LAS float*)(lds + 64512);
    LAS bf16_t* Q = (LAS bf16_t*)(lds + 66560);
    LAS float* T_N = (LAS float*)(lds + 100352);
    LAS bf16_t* NA = (LAS bf16_t*)(lds + 101376);
    const int tid = threadIdx.x, lane = tid & 63, w = tid >> 6, quad = lane >> 4, l16 = lane & 15;
    const bf16_t* z = (const bf16_t*)(P.ws + OFF_Z);
    float* obuf = (float*)(P.ws + OFF_OBUF);
    const int vcol = vs * 128 + w * 16, row0 = seq * 2048;
    f32x4 C[16];
#pragma unroll
    for (int dt = 0; dt < 16; ++dt) C[dt] = (f32x4){0.f, 0.f, 0.f, 0.f};
    float nreg = 0.f, m = 0.f;
    if (tid < 256) { T_N[tid] = 0.f; NA[tid] = 0; }
    u32x4 pre[14];
#define MLC_LOAD(cc) do { const unsigned char* blob_ = ml_blob(P, seq, head, (cc)); \
        _Pragma("unroll") for (int i = 0; i < 6; ++i) { const int p = tid + 512 * i; if (p < 2880) pre[i] = *(const u32x4*)(blob_ + (size_t)p * 16); } \
        _Pragma("unroll") for (int i = 0; i < 3; ++i) { const int p = tid + 512 * i; if (p < 1152) pre[6 + i] = *(const u32x4*)(blob_ + MLB_VT + vs * 18432 + (size_t)p * 16); } \
        if (tid < 128) pre[9] = *(const u32x4*)(blob_ + MLB_SC + tid * 16); \
        _Pragma("unroll") for (int i = 0; i < 4; ++i) { const int p = tid + 512 * i; pre[10 + i] = *(const u32x4*)(z + (size_t)(row0 + (cc) * 64 + (p >> 5)) * 6144 + head * 256 + (p & 31) * 8); } } while (0)
    MLC_LOAD(0);
    for (int c = 0; c < 32; ++c) {
        const int r0 = row0 + c * 64;
#pragma unroll
        for (int i = 0; i < 6; ++i) { const int p = tid + 512 * i; if (p < 2880) *(LAS u32x4*)(lds + p * 16) = pre[i]; }
#pragma unroll
        for (int i = 0; i < 3; ++i) { const int p = tid + 512 * i; if (p < 1152) *(LAS u32x4*)(lds + 46080 + p * 16) = pre[6 + i]; }
        if (tid < 128) *(LAS u32x4*)(lds + 64512 + tid * 16) = pre[9];
#pragma unroll
        for (int i = 0; i < 4; ++i) { const int p = tid + 512 * i; *(LAS u32x4*)(Q + (p >> 5) * QP + (p & 31) * 8) = pre[10 + i]; }
        if (c + 1 < 32) MLC_LOAD(c + 1);
        __syncthreads();
        const float pmall = SC[448], blast = SC[449];
        const float mxall = fmaxf(m, pmall), decay = __expf(m - mxall), factor = __expf(pmall - mxall);
        const float ksum = tid < 256 ? SC[192 + tid] : 0.f;
        bf16x8 sa[8];
#pragma unroll
        for (int ks = 0; ks < 8; ++ks) sa[ks] = mk8(cvt_pk_bf16(C[2 * ks][0], C[2 * ks][1]), cvt_pk_bf16(C[2 * ks][2], C[2 * ks][3]), cvt_pk_bf16(C[2 * ks + 1][0], C[2 * ks + 1][1]), cvt_pk_bf16(C[2 * ks + 1][2], C[2 * ks + 1][3]));
        bf16x8 vt[2];
#pragma unroll
        for (int k2s = 0; k2s < 2; ++k2s) vt[k2s] = *(const LAS bf16x8*)(VT + (w * 16 + l16) * LP + k2s * 32 + quad * 8);
#pragma unroll
        for (int tt = 0; tt < 4; ++tt) {
            const int t = tt * 16 + l16; f32x4 ai = {0.f, 0.f, 0.f, 0.f}, an = {0.f, 0.f, 0.f, 0.f}, as = {0.f, 0.f, 0.f, 0.f};
#pragma unroll
            for (int ks = 0; ks < 8; ++ks) {
                const u32x2 lo = *(const LAS u32x2*)(Q + t * QP + ks * 32 + quad * 4), hi = *(const LAS u32x2*)(Q + t * QP + ks * 32 + 16 + quad * 4);
                const bf16x8 qB = mk8(lo.x, lo.y, hi.x, hi.y);
                bf16x8 na = mk8(0, 0, 0, 0); if (l16 == 0) na = *(const LAS bf16x8*)(NA + (ks * 4 + quad) * 8);
                ai = MFMA16(sa[ks], qB, ai); an = MFMA16(na, qB, an); }
#pragma unroll
            for (int k2s = 0; k2s < 2; ++k2s) if (2 * k2s <= tt) { const bf16x8 B = *(const LAS bf16x8*)(SW + t * LP + k2s * 32 + quad * 8); as = MFMA16(vt[k2s], B, as); }
            const float nq = __shfl(an[0], l16);
            const float pmt = SC[t], bt = SC[64 + t], rst = SC[128 + t];
            const float mx = fmaxf(m, pmt), rowfac = __expf(pmt - mx), gi = __expf(m - mx), emt = __expf(-(bt + mx));
            const float den = rst * rowfac + gi * nq, rd = 1.f / fmaxf(fabsf(den), emt);
            *(f32x4*)(obuf + (size_t)(r0 + t) * 2048 + head * 512 + vcol + quad * 4) = (as * rowfac + ai * gi) * rd;
        }
        if (pmall - m > -60.f) {
            const float dscale = __expf(m - pmall);
#pragma unroll
            for (int dt = 0; dt < 16; ++dt) { f32x4 acc = C[dt] * dscale;
#pragma unroll
                for (int k2s = 0; k2s < 2; ++k2s) { const bf16x8 A = *(const LAS bf16x8*)(KTS + (dt * 16 + l16) * LP + k2s * 32 + quad * 8); acc = MFMA16(A, vt[k2s], acc); }
                C[dt] = acc * factor; }
        }
        m = blast + mxall;
        __syncthreads();
        if (tid < 256) { nreg = decay * nreg + factor * ksum; T_N[tid] = nreg;
            const int dt = tid >> 4, q = (tid >> 2) & 3, j = tid & 3; NA[((dt >> 1) * 4 + q) * 8 + (dt & 1) * 4 + j] = f2bf(nreg); }
    }
#pragma unroll
    for (int dt = 0; dt < 16; ++dt) *(f32x4*)(c_out + (size_t)(vcol + l16) * 256 + dt * 16 + quad * 4) = C[dt];
    if (vs == 0) { if (tid < 256) n_out[tid] = nreg; if (tid == 0) *m_out = m; }
    __syncthreads();
#undef MLC_LOAD
}

__device__ __forceinline__ void mixer0_phase(LAS unsigned char* lds, const Params& P) {
    const int b = blockIdx.x, G = gridDim.x, w = threadIdx.x >> 6;
    if (b < 32) {
        const int sh_ = 2 * (b & 7) + (b >> 4), vs = (b >> 3) & 1, seq = sh_ >> 2, head = sh_ & 3;
        gla_unit<64>(lds, P, head, vs, seq * 2048, 32, 64, nullptr, P.out + O_GLAP + (size_t)(seq * 4 + head) * 32768);
    } else if (b < 64) {
        const int u = (b - 32) * 8 + w, seq = u >> 6, g = u & 63;
        s5_wave(lds + w * 12800, P, g, seq * 2048, 128, 16, nullptr, nullptr, P.out + O_S5REP + (size_t)(seq * 64 + g) * 64, P.out + O_S5IMP + (size_t)(seq * 64 + g) * 64);
    } else {
        for (int u = b - 64; u < 1024 + 128; u += G - 64) {
            if (u < 1024) { const int ss = u >> 3, head = (u >> 1) & 3, vs = u & 1;
                gla_unit<32>(lds, P, head, vs, NPROMPT + ss * 8, 1, 8, P.in[I_SGLA] + (size_t)(ss * 4 + head) * 32768, P.out + O_GLAS + (size_t)(ss * 4 + head) * 32768);
            } else { const int u2 = (u - 1024) * 8 + w, g = u2 & 63, ss0 = (u2 >> 6) * 8;
                s5_wave(lds + w * 12800, P, g, NPROMPT + ss0 * 8, 1, 8, P.in[I_SS5RE] + (size_t)(ss0 * 64 + g) * 64, P.in[I_SS5IM] + (size_t)(ss0 * 64 + g) * 64,
                        P.out + O_S5RES + (size_t)(ss0 * 64 + g) * 64, P.out + O_S5IMS + (size_t)(ss0 * 64 + g) * 64, 8, 8, 4096);
                __syncthreads(); }
        }
        conv_items(lds, P, CONV_EARLY, CONV_ALL, b - 64, G - 64);
    }
}
__device__ __forceinline__ void mixer1_phase(LAS unsigned char* lds, const Params& P) {
    const int b = blockIdx.x, G = gridDim.x;
    if (b < 64) {
        const int sh_ = 2 * (b & 7) + (b >> 5), vs = (b >> 3) & 3, seq = sh_ >> 2, head = sh_ & 3;
        ml_chain(lds, P, seq, head, vs, P.out + O_MLCP + (size_t)(seq * 4 + head) * 131072, P.out + O_MLNP + (size_t)(seq * 4 + head) * 256, P.out + O_MLMP + seq * 4 + head);
    } else {
        for (int u = b - 64; u < 2048; u += G - 64) { const int ss = u >> 4, head = (u >> 2) & 3, vs = u & 3; const size_t sh = (size_t)(ss * 4 + head);
            ml_unit<32>(lds, P, head, vs, NPROMPT + ss * 8, 1, 8, P.in[I_SMLC] + sh * 131072, P.in[I_SMLN] + sh * 256, P.in[I_SMLM][sh], P.out + O_MLCS + sh * 131072, P.out + O_MLNS + sh * 256, P.out + O_MLMS + sh);
        }
    }
}
__device__ __forceinline__ void mlprep_phase(LAS unsigned char* lds, const Params& P) {
    for (int it = blockIdx.x; it < 512; it += gridDim.x) ml_prep(lds, P, it >> 7, (it >> 5) & 3, it & 31);
}
template <int HW>
__device__ __forceinline__ void post_phase(const Params& P) {
    const int lane = threadIdx.x & 63, w = threadIdx.x >> 6;
    const float* obuf = (const float*)(P.ws + OFF_OBUF); const bf16_t* z = (const bf16_t*)(P.ws + OFF_Z); bf16_t* mix = (bf16_t*)(P.ws + OFF_MIX);
    constexpr int NE = HW == 256 ? 4 : 8;
    const int ncol = HW == 256 ? 1024 : 2048, zp = HW == 256 ? 4096 : 6144, zoff = HW == 256 ? 2048 : 4096;
    const float* gsrc = HW == 256 ? P.in[I_GLANG] : P.in[I_MLONG];
    f32x4 g[NE];
#pragma unroll
    for (int e = 0; e < NE; ++e) g[e] = *(const f32x4*)(gsrc + e * 256 + lane * 4);
    for (int row = blockIdx.x * 8 + w; row < MROWS; row += gridDim.x * 8) {
        f32x4 o[NE]; u32x2 r[NE];
#pragma unroll
        for (int e = 0; e < NE; ++e) { o[e] = *(const f32x4*)(obuf + (size_t)row * 2048 + e * 256 + lane * 4); r[e] = *(const u32x2*)(z + (size_t)row * zp + zoff + e * 256 + lane * 4); }
        float ss[4];
#pragma unroll
        for (int h = 0; h < 4; ++h) { float a = 0.f;
#pragma unroll
            for (int e = h * (NE / 4); e < (h + 1) * (NE / 4); ++e) a += (o[e][0] * o[e][0] + o[e][1] * o[e][1]) + (o[e][2] * o[e][2] + o[e][3] * o[e][3]);
            ss[h] = a; }
#pragma unroll
        for (int of = 1; of < 64; of <<= 1) {
#pragma unroll
            for (int h = 0; h < 4; ++h) ss[h] += __shfl_xor(ss[h], of); }
#pragma unroll
        for (int e = 0; e < NE; ++e) { const float rs = rsqrtf(ss[e / (NE / 4)] * (1.f / HW) + EPS);
            float g0, g1, g2, g3;
            if (HW == 256) { g0 = siluf_(bflo(r[e].x)); g1 = siluf_(bfhi(r[e].x)); g2 = siluf_(bflo(r[e].y)); g3 = siluf_(bfhi(r[e].y)); }
            else { g0 = sigmoidf_(bflo(r[e].x)); g1 = sigmoidf_(bfhi(r[e].x)); g2 = sigmoidf_(bflo(r[e].y)); g3 = sigmoidf_(bfhi(r[e].y)); }
            u32x2 ov; ov.x = cvt_pk_bf16(o[e][0] * rs * g[e][0] * g0, o[e][1] * rs * g[e][1] * g1); ov.y = cvt_pk_bf16(o[e][2] * rs * g[e][2] * g2, o[e][3] * rs * g[e][3] * g3);
            *(u32x2*)(mix + (size_t)row * 2048 + e * 256 + lane * 4) = ov; }
        (void)ncol;
    }
}

__device__ __forceinline__ void upfix_phase(const Params& P) {
    const bf16_t* upart = (const bf16_t*)(P.ws + OFF_PART + 33554432); bf16_t* hh = (bf16_t*)(P.ws + OFF_HH);
    for (int it = blockIdx.x * NTHREADS + threadIdx.x; it < 48 * 256 * 16; it += gridDim.x * NTHREADS) {
        const int tr = it >> 12, rl = (it >> 4) & 255, jg = it & 15;
        const int pm = tr < 44 ? 35 : 34, pn = tr < 44 ? tr : 40 + (tr - 44);
        float a[8], b[8];
#pragma unroll
        for (int e = 0; e < 8; ++e) { a[e] = 0.f; b[e] = 0.f; }
#pragma unroll
        for (int ks = 0; ks < 4; ++ks) { const bf16_t* tb = upart + ((size_t)ks * 48 + tr) * 65536 + (size_t)rl * 256 + jg * 8;
            const u32x4 av = *(const u32x4*)tb, bv = *(const u32x4*)(tb + 128);
            a[0] += bflo(av.x); a[1] += bfhi(av.x); a[2] += bflo(av.y); a[3] += bfhi(av.y); a[4] += bflo(av.z); a[5] += bfhi(av.z); a[6] += bflo(av.w); a[7] += bfhi(av.w);
            b[0] += bflo(bv.x); b[1] += bfhi(bv.x); b[2] += bflo(bv.y); b[3] += bfhi(bv.y); b[4] += bflo(bv.z); b[5] += bfhi(bv.z); b[6] += bflo(bv.w); b[7] += bfhi(bv.w); }
        u32x4 o; o.x = cvt_pk_bf16(siluf_(a[0]) * b[0], siluf_(a[1]) * b[1]); o.y = cvt_pk_bf16(siluf_(a[2]) * b[2], siluf_(a[3]) * b[3]);
        o.z = cvt_pk_bf16(siluf_(a[4]) * b[4], siluf_(a[5]) * b[5]); o.w = cvt_pk_bf16(siluf_(a[6]) * b[6], siluf_(a[7]) * b[7]);
        *(u32x4*)(hh + (size_t)(pm * 256 + rl) * DFF + pn * 128 + jg * 8) = o;
    }
}
#define XB_TMO      128
#define XB_XCNT(j)  (256  + 64 * (j))
#define XB_XSUB(j)  (1280 + 64 * (j))
#define XB_XGEN(j)  (2304 + 64 * (j))
#define XB_TOP      3328
#define XB_TOPGEN   3392
#define XCD_BAR_WORDS 3456
#define XB_SPIN_CAP (1u << 22)
__device__ __forceinline__ unsigned xb_ld(unsigned* p)              { return __hip_atomic_load(p, __ATOMIC_RELAXED, __HIP_MEMORY_SCOPE_AGENT); }
__device__ __forceinline__ unsigned xb_add(unsigned* p, unsigned v) { return __hip_atomic_fetch_add(p, v, __ATOMIC_RELAXED, __HIP_MEMORY_SCOPE_AGENT); }
__device__ __forceinline__ unsigned xb_xcc_id() { return (unsigned)__builtin_amdgcn_s_getreg((3 << 11) | 20) & 0xFu; }
#define XB_SPIN(cond, bar) do { unsigned _sp = 0; while (cond) { __builtin_amdgcn_s_sleep(1); \
    if ((++_sp & 255u) == 0u) { if (xb_ld(&(bar)[XB_TMO])) break; if (_sp > XB_SPIN_CAP) { atomicAdd(&(bar)[XB_TMO], 1u); break; } } } } while (0)
struct XcdBarrier { unsigned* bar; unsigned x; volatile LAS unsigned* st; };
__device__ __forceinline__ XcdBarrier xcd_barrier_post(unsigned* bar, volatile LAS unsigned* st) {
    XcdBarrier b; b.bar = bar; b.x = xb_xcc_id(); b.st = st;
    if (threadIdx.x == 0) (void)xb_add(&bar[XB_XCNT(b.x)], 1u);
    return b;
}
__device__ __forceinline__ void xcd_barrier_complete(unsigned* bar, unsigned x, unsigned& nloc, unsigned& nx) {
    const unsigned G = gridDim.x * gridDim.y * gridDim.z;
    unsigned sum, cnt, mine, sp = 0u;
    for (;;) {
        sum = 0u; cnt = 0u; mine = 0u;
#pragma unroll
        for (unsigned j = 0; j < 16; ++j) { const unsigned c = xb_ld(&bar[XB_XCNT(j)]); sum += c; cnt += (c > 0u) ? 1u : 0u; mine = (j == x) ? c : mine; }
        if (sum == G) break;
        __builtin_amdgcn_s_sleep(1);
        if ((++sp & 255u) == 0u) { if (xb_ld(&bar[XB_TMO])) break; if (sp > XB_SPIN_CAP) { atomicAdd(&bar[XB_TMO], 1u); break; } }
    }
    nloc = mine > 0u ? mine : 1u; nx = cnt > 0u ? cnt : 1u;
}
__device__ __forceinline__ void xcd_barrier(const XcdBarrier& b) {
    asm volatile("s_waitcnt vmcnt(0)" ::: "memory");
    __syncthreads();
    if (threadIdx.x == 0) {
        unsigned* bar = b.bar;
        __builtin_amdgcn_s_waitcnt(0);
        unsigned nloc = b.st[0], nx = b.st[1];
        if (nloc == 0u) { xcd_barrier_complete(bar, b.x, nloc, nx); b.st[0] = nloc; b.st[1] = nx; }
        const unsigned old = xb_add(&bar[XB_XSUB(b.x)], 1u);
        const unsigned gen = old / nloc;
        if (old + 1u == (gen + 1u) * nloc) {
            __builtin_amdgcn_fence(__ATOMIC_RELEASE, "agent");
            asm volatile("s_waitcnt vmcnt(0)" ::: "memory");
            const unsigned og = xb_add(&bar[XB_TOP], 1u);
            const unsigned tg = og / nx;
            if (og + 1u == (tg + 1u) * nx) xb_add(&bar[XB_TOPGEN], 1u);
            else XB_SPIN(xb_ld(&bar[XB_TOPGEN]) == tg, bar);
            __builtin_amdgcn_fence(__ATOMIC_ACQUIRE, "agent");
            xb_add(&bar[XB_XGEN(b.x)], 1u);
            asm volatile("s_waitcnt vmcnt(0)" ::: "memory");
        } else {
            XB_SPIN(xb_ld(&bar[XB_XGEN(b.x)]) == gen, bar);
            __builtin_amdgcn_fence(__ATOMIC_ACQUIRE, "agent");
            asm volatile("s_waitcnt vmcnt(0)" ::: "memory");
        }
    }
    __syncthreads();
}

__global__ void __launch_bounds__(NTHREADS, 2) trunk_fwd(Params P) {
    extern __shared__ __attribute__((aligned(16))) unsigned char lds_raw[];
    LAS unsigned char* lds = (LAS unsigned char*)lds_raw;
    const int lo = P.ph_lo, hi = P.ph_hi;
    const int G = gridDim.x, bx = blockIdx.x;
    unsigned char* ws = P.ws;
    const float* mod = (const float*)(ws + OFF_MOD);
    float* xcur = (float*)(ws + OFF_XCUR);
    float* part = (float*)(ws + OFF_PART);
    bf16_t* hA = (bf16_t*)(ws + OFF_HA); bf16_t* z = (bf16_t*)(ws + OFF_Z); bf16_t* mix = (bf16_t*)(ws + OFF_MIX); bf16_t* hh = (bf16_t*)(ws + OFF_HH);
#ifndef PH_MASK
#define PH_MASK 0x7FFFF
#endif
#define IN(k) ((((PH_MASK) >> (k)) & 1) && lo <= (k) && (k) < hi)
    volatile LAS unsigned* xst = (volatile LAS unsigned*)(lds + LDS_BYTES - 64);
    XcdBarrier bar; bar.bar = (unsigned*)(ws + OFF_CTL); bar.x = 0; bar.st = xst;
    if (hi - lo > 1) { if (threadIdx.x < 2) xst[threadIdx.x] = 0u; __syncthreads(); bar = xcd_barrier_post((unsigned*)(ws + OFF_CTL), xst); }
    if (lo > 1000) cg::this_grid().sync();
#define SEAM(k) do { if (IN(k) && IN((k) + 1)) { xcd_barrier(bar); } } while (0)
#define GEMM(EPI, E, Aptr, Bptr, Mm, Nn, Kk) do { pg8::Gemm g_{(Aptr), (Bptr), (Mm), (Nn), (Kk)}; pg8::StaticOrder S_; S_.init((Mm), (Nn), (Kk), G, bx); pg8::gemm_phase<EPI, pg8::StaticOrder>(lds, g_, S_, E); } while (0)
#define GEMM_SPLIT(EPI, E, Aptr, Bptr, Kk) do { pg8::Gemm g_{(Aptr), (Bptr), MROWS, DM, (Kk)}; if (G == 256) { pg8::SplitOrder S_; S_.init((Kk), G, bx); pg8::gemm_phase<EPI, pg8::SplitOrder>(lds, g_, S_, E); } \
        else { pg8::StaticOrder S_; S_.init(MROWS, DM, (Kk), G, bx); pg8::gemm_phase<EPI, pg8::StaticOrder>(lds, g_, S_, E); } } while (0)
    if (IN(0)) { p0_prologue(lds, P); } SEAM(0);
    if (IN(1)) { EpiAda E{(float*)(ws + OFF_MOD), (const float*)(ws + OFF_BADA)};
                 GEMM(EpiAda, E, (const bf16_t*)(ws + OFF_CS), (const bf16_t*)(ws + OFF_WADA), 256, 6144, DM);
                 if (G > 24) { if (bx >= 24) conv_items(lds, P, 768, CONV_EARLY, bx - 24, G - 24); } else conv_items(lds, P, 768, CONV_EARLY, bx, G); } SEAM(1);
    if (IN(2)) { norm_phase<0>(lds, P, P.in[I_ABNG], 0, -1); } SEAM(2);
    if (IN(3)) { EpiBf16 E{z, 4096}; GEMM(EpiBf16, E, hA, (const bf16_t*)(ws + OFF_WABIN), MROWS, 4096, DM);
                 { const int rem_ = 576 % G; const int rk_ = bx - rem_, ng_ = G - rem_;
                   if (rk_ >= 0) { EpiAda E2{(float*)(ws + OFF_MOD) + 6144, (const float*)(ws + OFF_BADA) + 6144};
                       pg8::Gemm g2{(const bf16_t*)(ws + OFF_CS), (const bf16_t*)(ws + OFF_WADA) + (size_t)6144 * DM, 256, 18432, DM};
                       pg8::StaticOrder S2; S2.init(256, 18432, DM, ng_, rk_); pg8::gemm_phase<EpiAda, pg8::StaticOrder>(lds, g2, S2, E2); } } } SEAM(3);
    if (IN(4)) { mixer0_phase(lds, P); } SEAM(4);
    if (IN(5)) { post_phase<256>(P);
                 EpiGlu E{(const bf16_t*)(ws + OFF_YG), mix, P.in[I_S5BGLU]}; GEMM(EpiGlu, E, (const bf16_t*)(ws + OFF_YG), (const bf16_t*)(ws + OFF_WGLU), MROWS, 1024, 1024); } SEAM(5);
    if (IN(6)) { EpiResid E{P.in[I_XP], P.in[I_XS], xcur, mod + 0 * 6144 + 4096, part}; GEMM_SPLIT(EpiResid, E, mix, (const bf16_t*)(ws + OFF_WABOUT), DM); } SEAM(6);
    if (IN(7)) { norm_phase<1>(lds, P, P.in[I_FNG], 1, 0); } SEAM(7);
    if (IN(8)) { EpiSwiglu E{hh};
                 if (G == 256) { pg8::Gemm g_{hA, (const bf16_t*)(ws + OFF_WF13), MROWS, 11264, DM}; pg8::UpOrder S_; S_.init(DM, bx); pg8::gemm_phase<EpiSwiglu, pg8::UpOrder>(lds, g_, S_, E);
                                 EpiUpPart E2{(bf16_t*)(ws + OFF_PART + 33554432)}; pg8::UpRem S2; S2.init(DM, bx); pg8::gemm_phase<EpiUpPart, pg8::UpRem>(lds, g_, S2, E2);
                                 xcd_barrier(bar); upfix_phase(P); }
                 else GEMM(EpiSwiglu, E, hA, (const bf16_t*)(ws + OFF_WF13), MROWS, 11264, DM); } SEAM(8);
    if (IN(9)) { EpiResid E{xcur, xcur + (size_t)NPROMPT * DM, xcur, mod + 1 * 6144 + 4096, part}; GEMM_SPLIT(EpiResid, E, hh, (const bf16_t*)(ws + OFF_WF2), DFF); } SEAM(9);
    if (IN(10)) { norm_phase<2>(lds, P, P.in[I_MLNG], 2, 1); } SEAM(10);
    if (IN(11)) { EpiBf16 E{z, 6144}; GEMM(EpiBf16, E, hA, (const bf16_t*)(ws + OFF_WMLIN), MROWS, 6144, DM); } SEAM(11);
    if (IN(12)) { mlprep_phase(lds, P); xcd_barrier(bar); mixer1_phase(lds, P); } SEAM(12);
    if (IN(13)) { post_phase<512>(P); } SEAM(13);
    if (IN(14)) { EpiResid E{xcur, xcur + (size_t)NPROMPT * DM, xcur, mod + 2 * 6144 + 4096, part}; GEMM_SPLIT(EpiResid, E, mix, (const bf16_t*)(ws + OFF_WMLOUT), DM); } SEAM(14);
    if (IN(15)) { norm_phase<1>(lds, P, P.in[I_FNG] + DM, 3, 2); } SEAM(15);
    if (IN(16)) { EpiSwiglu E{hh};
                 if (G == 256) { pg8::Gemm g_{hA, (const bf16_t*)(ws + OFF_WF13) + (size_t)11264 * DM, MROWS, 11264, DM}; pg8::UpOrder S_; S_.init(DM, bx); pg8::gemm_phase<EpiSwiglu, pg8::UpOrder>(lds, g_, S_, E);
                                 EpiUpPart E2{(bf16_t*)(ws + OFF_PART + 33554432)}; pg8::UpRem S2; S2.init(DM, bx); pg8::gemm_phase<EpiUpPart, pg8::UpRem>(lds, g_, S2, E2);
                                 xcd_barrier(bar); upfix_phase(P); }
                 else GEMM(EpiSwiglu, E, hA, (const bf16_t*)(ws + OFF_WF13) + (size_t)11264 * DM, MROWS, 11264, DM); } SEAM(16);
    if (IN(17)) { EpiResid E{xcur, xcur + (size_t)NPROMPT * DM, xcur, mod + 3 * 6144 + 4096, part}; GEMM_SPLIT(EpiResid, E, hh, (const bf16_t*)(ws + OFF_WF2) + (size_t)DM * DFF, DFF); } SEAM(17);
    if (IN(18)) { norm_phase<3>(lds, P, P.in[I_FINALG], 0, 3); }
#undef IN
#undef SEAM
#undef GEMM
}

extern "C" void kernel_launch(void* const* d_in, const int* in_sizes, int n_in, void* d_out, int out_size, void* d_ws, size_t ws_size, hipStream_t stream) {
    static int grid = 0;
    if (grid == 0) {
        if (n_in != N_IN || (size_t)out_size != O_END || ws_size < WS_END) { fprintf(stderr, "kernel_launch: unexpected sizes n_in %d out %d ws %zu (need %d, %zu, %zu)\n", n_in, out_size, ws_size, (int)N_IN, (size_t)O_END, (size_t)WS_END); grid = -1; return; }
        int dev = 0, cus = 0, per_cu = 0;
        (void)hipGetDevice(&dev); (void)hipDeviceGetAttribute(&cus, hipDeviceAttributeMultiprocessorCount, dev);
        if (hipFuncSetAttribute((const void*)trunk_fwd, hipFuncAttributeMaxDynamicSharedMemorySize, LDS_BYTES) != hipSuccess) { fprintf(stderr, "kernel_launch: hipFuncSetAttribute failed\n"); grid = -1; return; }
        if (hipOccupancyMaxActiveBlocksPerMultiprocessor(&per_cu, (const void*)trunk_fwd, NTHREADS, LDS_BYTES) != hipSuccess || per_cu < 1) { fprintf(stderr, "kernel_launch: occupancy query says %d\n", per_cu); per_cu = 1; }
        (void)hipGetLastError();
        grid = cus * 1;
        if (grid < 128) { fprintf(stderr, "kernel_launch: grid %d too small\n", grid); grid = -1; return; }
    }
    if (grid < 0) return;
    Params p{};
    for (int i = 0; i < N_IN; ++i) p.in[i] = (const float*)d_in[i];
    p.out = (float*)d_out; p.ws = (unsigned char*)d_ws;
#if MK_PER_PHASE
    for (int ph = 0; ph < NPH; ++ph) { p.ph_lo = ph; p.ph_hi = ph + 1;
        hipLaunchKernelGGL(trunk_fwd, dim3(grid), dim3(NTHREADS), LDS_BYTES, stream, p);
        const hipError_t le = hipPeekAtLastError(); if (le != hipSuccess) { fprintf(stderr, "kernel_launch: launch %d failed: %s\n", ph, hipGetErrorName(le)); break; } }
#else
    p.ph_lo = 0; p.ph_hi = NPH;
    if (hipMemsetAsync((char*)d_ws + OFF_CTL, 0, CTL_BYTES, stream) != hipSuccess) { fprintf(stderr, "kernel_launch: memset failed\n"); return; }
    void* args[] = {&p};
    const hipError_t e = hipLaunchCooperativeKernel((const void*)trunk_fwd, dim3(grid), dim3(NTHREADS), args, LDS_BYTES, stream);
    if (e != hipSuccess) fprintf(stderr, "kernel_launch: cooperative launch failed: %s (grid %d)\n", hipGetErrorString(e), grid);
#endif
}
```

```cpp
#include <hip/hip_runtime.h>
#include <hip/hip_cooperative_groups.h>
#include <cstdio>
#include <cstdint>
namespace cg = cooperative_groups;

#ifndef MK_PER_PHASE
#define MK_PER_PHASE 0
#endif

#define LAS __attribute__((address_space(3)))
typedef unsigned short bf16_t;
typedef short bf16x8 __attribute__((ext_vector_type(8)));
typedef float f32x4 __attribute__((ext_vector_type(4)));
typedef float f32x2 __attribute__((ext_vector_type(2)));
typedef unsigned u32x4 __attribute__((ext_vector_type(4)));
typedef unsigned u32x2 __attribute__((ext_vector_type(2)));

constexpr int DM = 2048, NPROMPT = 8192, MROWS = 9216, NSEQ = 132, DFF = 5632;
constexpr int NPH = 19;
constexpr int LDS_BYTES = 147456;
constexpr int NTHREADS = 512;
constexpr float EPS = 1e-6f;

constexpr size_t OFF_WADA = 0;
constexpr size_t OFF_WABIN = OFF_WADA + 100663296;
constexpr size_t OFF_WGLU = OFF_WABIN + 16777216;
constexpr size_t OFF_WABOUT = OFF_WGLU + 2097152;
constexpr size_t OFF_WF13 = OFF_WABOUT + 8388608;
constexpr size_t OFF_WF2 = OFF_WF13 + 92274688;
constexpr size_t OFF_WMLIN = OFF_WF2 + 46137344;
constexpr size_t OFF_WMLOUT = OFF_WMLIN + 25165824;
constexpr size_t OFF_WGLR = OFF_WMLOUT + 8388608;
constexpr size_t OFF_WMLG = OFF_WGLR + 131072;
constexpr size_t OFF_CS = OFF_WMLG + 65536;
constexpr size_t OFF_MOD = OFF_CS + 1048576;
constexpr size_t OFF_XCUR = OFF_MOD + 25165824;
constexpr size_t OFF_HA = OFF_XCUR + 75497472;
constexpr size_t OFF_Z = OFF_HA + 37748736;
constexpr size_t OFF_LA = OFF_Z + 113246208;
constexpr size_t OFF_GT = OFF_LA + 18874368;
constexpr size_t OFF_OBUF = OFF_GT + 294912;
constexpr size_t OFF_YG = OFF_OBUF + 75497472;
constexpr size_t OFF_MIX = OFF_YG + 18874368;
constexpr size_t OFF_HH = OFF_MIX + 37748736;
constexpr size_t OFF_BADA = OFF_HH + 103809024;
constexpr size_t OFF_PART = OFF_BADA + 98304;
constexpr size_t OFF_CTL = OFF_PART + 67108864;
constexpr size_t CTL_BYTES = 16384;
constexpr size_t WS_END = OFF_CTL + CTL_BYTES;

constexpr size_t O_YP = 0, O_YS = 16777216, O_GLAP = 18874368, O_S5REP = 19398656, O_S5IMP = 19415040, O_MLCP = 19431424,
                 O_MLNP = 21528576, O_MLMP = 21532672, O_GLAS = 21532688, O_S5RES = 38309904, O_S5IMS = 38834192,
                 O_MLCS = 39358480, O_MLNS = 106467344, O_MLMS = 106598416, O_END = 106598928;

enum { I_XP = 0, I_XS, I_CP, I_CS, I_SGLA, I_SS5RE, I_SS5IM, I_SMLC, I_SMLN, I_SMLM, I_ABADAW, I_ABADAB, I_ABNG, I_ABWIN, I_GLAWG, I_GLABG,
       I_GLANG, I_S5LRE, I_S5LIM, I_S5LDT, I_S5BRE, I_S5BIM, I_S5CRE, I_S5CIM, I_S5D, I_S5WGLU, I_S5BGLU, I_ABWOUT, I_MLADAW, I_MLADAB,
       I_MLNG, I_MLWIN, I_MLBI, I_MLBF, I_MLONG, I_MLWOUT, I_FADAW, I_FADAB, I_FNG, I_FW1, I_FW3, I_FW2, I_FINALG, N_IN };

struct Params { const float* in[N_IN]; float* out; unsigned char* ws; int ph_lo, ph_hi; };

__device__ __forceinline__ float wave_sum(float v) {
#pragma unroll
    for (int o = 1; o < 64; o <<= 1) v += __shfl_xor(v, o);
    return v;
}
__device__ __forceinline__ unsigned cvt_pk_bf16(float lo, float hi) { unsigned r; asm volatile("v_cvt_pk_bf16_f32 %0, %1, %2" : "=v"(r) : "v"(lo), "v"(hi)); return r; }
__device__ __forceinline__ bf16_t f2bf(float f) { return (bf16_t)(cvt_pk_bf16(f, 0.f) & 0xffffu); }
__device__ __forceinline__ float bf2f(unsigned b) { return __uint_as_float(b << 16); }
__device__ __forceinline__ float bflo(unsigned w) { return __uint_as_float(w << 16); }
__device__ __forceinline__ float bfhi(unsigned w) { return __uint_as_float(w & 0xffff0000u); }
__device__ __forceinline__ float sigmoidf_(float x) { return __builtin_amdgcn_rcpf(1.f + __expf(-x)); }
__device__ __forceinline__ float siluf_(float x) { return x * __builtin_amdgcn_rcpf(1.f + __expf(-x)); }
__device__ __forceinline__ float logsigmoidf_(float x) { return fminf(x, 0.f) - __logf(1.f + __expf(-fabsf(x))); }
__device__ __forceinline__ float gelu_tanh(float y) { const float u = 0.7978845608028654f * (y + 0.044715f * y * y * y); const float t = 1.f - 2.f * __builtin_amdgcn_rcpf(__expf(2.f * u) + 1.f); return 0.5f * y * (1.f + t); }
__device__ __forceinline__ int row_seq(int row) { return row < NPROMPT ? (row >> 11) : 4 + ((row - NPROMPT) >> 3); }
__device__ __forceinline__ bf16x8 mk8(unsigned a, unsigned b, unsigned c, unsigned d) { u32x4 v = {a, b, c, d}; return __builtin_bit_cast(bf16x8, v); }
#define MFMA16(a, b, c) __builtin_amdgcn_mfma_f32_16x16x32_bf16((a), (b), (c), 0, 0, 0)
#define LDS_FENCE() asm volatile("s_waitcnt lgkmcnt(0)" ::: "memory")

namespace pg8 {
constexpr int BM = 256, BK = 64, HALF = 128, HTB = HALF * BK * 2, NXCD = 8, WGM = 8;
__host__ __device__ __forceinline__ int lds_byte(int r, int c) { const int st = (r >> 4) * 2 + (c >> 5), rr = r & 15, cc = c & 31, ob = rr * 64 + cc * 2; return st * 1024 + (ob ^ (((ob >> 9) & 1) << 5)); }
__host__ __device__ __forceinline__ void stage_rc(int b, int& R, int& C) { const int st = b / 1024, sb = b % 1024, swz = sb ^ (((sb >> 9) & 1) << 5); R = (st >> 1) * 16 + swz / 64; C = (st & 1) * 32 + (swz % 64) / 2; }
__host__ __device__ __forceinline__ int perm32(int rho) { const int n = rho >> 4, i = rho & 15; return 8 * (i >> 2) + 4 * n + (i & 3); }
struct Unit { int pm, pn, kt0, nkt, ks; };
struct Gemm { const bf16_t* A; const bf16_t* Bt; int M, N, K; };
struct StaticOrder {
    int nM, nN, nwg, G, c, nkt;
    __device__ void init(int M, int N, int K, int G_, int c_) { nM = M / BM; nN = N / BM; nwg = nM * nN; G = G_; c = c_; nkt = K / BK; }
    __device__ bool next(int i, Unit& u) const {
        const long L = (long)i * G + c; if (L >= nwg) return false;
        int wgid = (int)L; { const int q = nwg / NXCD, r = nwg % NXCD, xcd = wgid % NXCD, off = wgid / NXCD; wgid = (xcd < r ? xcd * (q + 1) : r * (q + 1) + (xcd - r) * q) + off; }
        const int nig = WGM * nN, gid = wgid / nig, fm = gid * WGM, gsz = (nM - fm) < WGM ? (nM - fm) : WGM;
        u.pm = fm + ((wgid % nig) % gsz); u.pn = (wgid % nig) / gsz; u.kt0 = 0; u.nkt = nkt; u.ks = -1; return true;
    }
};
struct SplitOrder {
    int c, nkt, ok;
    __device__ void init(int K, int G_, int c_) { c = c_; nkt = K / BK; ok = (G_ == 256); }
    __device__ bool next(int i, Unit& u) const {
        if (i == 0) { const int xcd = c & 7, j = c >> 3; u.pm = xcd * 4 + (j >> 3); u.pn = j & 7; u.kt0 = 0; u.nkt = nkt; u.ks = -1; return true; }
        if (i == 1) { const int tl = c & 31, ks = c >> 5; u.pm = 32 + (tl >> 3); u.pn = tl & 7; u.ks = ks;
            if (nkt == 32) { u.kt0 = ks * 4; u.nkt = 4; } else { u.kt0 = (ks >> 1) * 22 + (ks & 1) * 12; u.nkt = (ks & 1) ? 10 : 12; }
            return true; }
        return false;
    }
};
struct UpOrder {
    int c, nkt;
    __device__ void init(int K, int c_) { c = c_; nkt = K / BK; }
    __device__ bool next(int i, Unit& u) const {
        const int L = i * 256 + c;
        if (L < 1496) { const int nM = 34, nN = 44, nwg = 1496;
            int wgid = L; { const int q = nwg / NXCD, r = nwg % NXCD, xcd = wgid % NXCD, off = wgid / NXCD; wgid = (xcd < r ? xcd * (q + 1) : r * (q + 1) + (xcd - r) * q) + off; }
            const int nig = WGM * nN, gid = wgid / nig, fm = gid * WGM, gsz = (nM - fm) < WGM ? (nM - fm) : WGM;
            u.pm = fm + ((wgid % nig) % gsz); u.pn = (wgid % nig) / gsz; u.kt0 = 0; u.nkt = nkt; u.ks = -1; return true; }
        if (L < 1536) { u.pm = 34; u.pn = L - 1496; u.kt0 = 0; u.nkt = nkt; u.ks = -1; return true; }
        return false;
    }
};
struct UpRem {
    int c, nkt;
    __device__ void init(int K, int c_) { c = c_; nkt = K / BK; }
    __device__ bool next(int i, Unit& u) const {
        if (i != 0 || c >= 192) return false;
        const int tr = c % 48, ks = c / 48;
        if (tr < 44) { u.pm = 35; u.pn = tr; } else { u.pm = 34; u.pn = 40 + (tr - 44); }
        u.ks = ks; u.kt0 = ks * (nkt / 4); u.nkt = nkt / 4; return true;
    }
};
template <class Epi, class Sched>
__device__ __forceinline__ void gemm_phase(LAS unsigned char* lds, const Gemm g, const Sched& S, const Epi& E) {
    const int tid = threadIdx.x, wid = __builtin_amdgcn_readfirstlane(tid >> 6), lane = tid & 63, wr = wid >> 2, wc = wid & 3, fr = lane & 15, fq = lane >> 4;
    const int K = g.K;
    unsigned voffA[2], voffB[2];
#pragma unroll
    for (int i = 0; i < 2; ++i) { int R, C; stage_rc(tid * 16 + i * 8192, R, C); const int Rb = Epi::PERM ? ((R & ~31) + perm32(R & 31)) : R;
        voffA[i] = (unsigned)(R * K + C) * 2u; voffB[i] = (unsigned)(Rb * K + C) * 2u; }
    const size_t kstep = (size_t)(BK * 2);
    const size_t hstep = (size_t)HALF * K * 2;
    const size_t tstep = 2 * hstep;
    const unsigned ldsw = (unsigned)wid * 1024u;
    const int aoff = lds_byte(wr * 64 + fr, fq * 8), boff = lds_byte(wc * 32 + fr, fq * 8);
#define PG8_SA(b, h) (((b) * 2 + (h)) * HTB)
#define PG8_SB(b, h) ((4 + (b) * 2 + (h)) * HTB)
#define PG8_STAGE(bufoff, gbase, voff) do { _Pragma("unroll") for (int _i = 0; _i < 2; ++_i) \
        __builtin_amdgcn_global_load_lds((const unsigned*)((const char*)(gbase) + (voff)[_i]), (LAS unsigned*)(lds + (bufoff) + ldsw + _i * 8192), 16, 0, 0); } while (0)
#define PG8_LDA(dst, b, h) do { _Pragma("unroll") for (int m = 0; m < 4; ++m) _Pragma("unroll") for (int k = 0; k < 2; ++k) dst[m][k] = *(const LAS bf16x8*)(lds + PG8_SA(b, h) + aoff + m * 2048 + k * 1024); } while (0)
#define PG8_LDB(dst, b, h) do { _Pragma("unroll") for (int n = 0; n < 2; ++n) _Pragma("unroll") for (int k = 0; k < 2; ++k) dst[n][k] = *(const LAS bf16x8*)(lds + PG8_SB(b, h) + boff + n * 2048 + k * 1024); } while (0)
#define PG8_MMA(ai, bj, At, Bt) do { __builtin_amdgcn_s_setprio(1); _Pragma("unroll") for (int m = 0; m < 4; ++m) _Pragma("unroll") for (int n = 0; n < 2; ++n) _Pragma("unroll") for (int k = 0; k < 2; ++k) \
        acc[ai][bj][m][n] = __builtin_amdgcn_mfma_f32_16x16x32_bf16(Bt[n][k], At[m][k], acc[ai][bj][m][n], 0, 0, 0); __builtin_amdgcn_s_setprio(0); } while (0)
#define PG8_WAIT_V(n) asm volatile("s_waitcnt vmcnt(" #n ")" ::: "memory")
#define PG8_WAIT_L(n) asm volatile("s_waitcnt lgkmcnt(" #n ")" ::: "memory")
#define PG8_BAR __builtin_amdgcn_s_barrier()
#define PG8_SCHED __builtin_amdgcn_sched_barrier(0)
    Unit cur, nxt; int ui = 0;
    if (!S.next(0, cur)) return;
    f32x4 acc[2][2][4][2];
#pragma unroll
    for (int a = 0; a < 2; ++a)
#pragma unroll
        for (int b = 0; b < 2; ++b)
#pragma unroll
            for (int m = 0; m < 4; ++m)
#pragma unroll
                for (int n = 0; n < 2; ++n) acc[a][b][m][n] = (f32x4){0.f, 0.f, 0.f, 0.f};
    bf16x8 At[4][2], B0[2][2], B1[2][2];
    const char* cA = (const char*)g.A + (size_t)cur.pm * tstep + (size_t)cur.kt0 * kstep; const char* cB = (const char*)g.Bt + (size_t)cur.pn * tstep + (size_t)cur.kt0 * kstep;
    PG8_STAGE(PG8_SB(0, 0), cB, voffB); PG8_STAGE(PG8_SB(0, 1), cB + hstep, voffB); PG8_STAGE(PG8_SA(0, 0), cA, voffA); PG8_STAGE(PG8_SA(0, 1), cA + hstep, voffA);
    if (wr == 1) PG8_BAR;
    PG8_WAIT_V(2); PG8_BAR;
    PG8_STAGE(PG8_SB(1, 0), cB + kstep, voffB); PG8_STAGE(PG8_SA(1, 0), cA + kstep, voffA); PG8_STAGE(PG8_SB(1, 1), cB + hstep + kstep, voffB);
    PG8_WAIT_V(6); PG8_BAR;
    for (;;) {
        const bool has_next = S.next(ui + 1, nxt);
        const char* nA = has_next ? (const char*)g.A + (size_t)nxt.pm * tstep + (size_t)nxt.kt0 * kstep : cA; const char* nB = has_next ? (const char*)g.Bt + (size_t)nxt.pn * tstep + (size_t)nxt.kt0 * kstep : cB;
        const int nt = cur.nkt;
        for (int t = 0; t < nt; t += 2) {
            const bool last = (t == nt - 2);
            const char* a1 = cA + (size_t)(t + 1) * kstep;
            const char* a2 = last ? nA : cA + (size_t)(t + 2) * kstep; const char* b2 = last ? nB : cB + (size_t)(t + 2) * kstep;
            const char* a3 = a2 + kstep; const char* b3 = b2 + kstep;
            PG8_LDB(B0, 0, 0); PG8_LDB(B1, 0, 1); PG8_SCHED; PG8_LDA(At, 0, 0); PG8_STAGE(PG8_SA(1, 1), a1 + hstep, voffA);
            PG8_WAIT_V(8); PG8_WAIT_L(0); PG8_BAR; PG8_MMA(0, 0, At, B0); PG8_MMA(0, 1, At, B1); PG8_BAR; PG8_SCHED;
            PG8_LDA(At, 0, 1); PG8_STAGE(PG8_SB(0, 0), b2, voffB); PG8_STAGE(PG8_SB(0, 1), b2 + hstep, voffB); PG8_STAGE(PG8_SA(0, 0), a2, voffA);
            PG8_WAIT_V(8); PG8_WAIT_L(0); PG8_BAR; PG8_MMA(1, 0, At, B0); PG8_MMA(1, 1, At, B1); PG8_BAR; PG8_SCHED;
            PG8_LDB(B0, 1, 0); PG8_LDB(B1, 1, 1); PG8_SCHED; PG8_LDA(At, 1, 0); PG8_STAGE(PG8_SA(0, 1), a2 + hstep, voffA);
            PG8_WAIT_V(8); PG8_WAIT_L(0); PG8_BAR; PG8_MMA(0, 0, At, B0); PG8_MMA(0, 1, At, B1); PG8_BAR; PG8_SCHED;
            PG8_LDA(At, 1, 1); PG8_STAGE(PG8_SB(1, 0), b3, voffB); PG8_STAGE(PG8_SB(1, 1), b3 + hstep, voffB); PG8_STAGE(PG8_SA(1, 0), a3, voffA);
            PG8_WAIT_V(8); PG8_WAIT_L(0); PG8_BAR; PG8_MMA(1, 0, At, B0); PG8_MMA(1, 1, At, B1); PG8_BAR; PG8_SCHED;
        }
        if (wr == 0) PG8_BAR;
        E(acc, cur, wr, wc, fr, fq);
        if (!has_next) break;
#pragma unroll
        for (int a = 0; a < 2; ++a)
#pragma unroll
            for (int b = 0; b < 2; ++b)
#pragma unroll
                for (int m = 0; m < 4; ++m)
#pragma unroll
                    for (int n = 0; n < 2; ++n) acc[a][b][m][n] = (f32x4){0.f, 0.f, 0.f, 0.f};
        cur = nxt; cA = nA; cB = nB; ++ui;
        if (wr == 1) PG8_BAR;
    }
    PG8_WAIT_V(0);
    PG8_BAR;
#undef PG8_SA
#undef PG8_SB
#undef PG8_STAGE
#undef PG8_LDA
#undef PG8_LDB
#undef PG8_MMA
#undef PG8_WAIT_V
#undef PG8_WAIT_L
#undef PG8_BAR
#undef PG8_SCHED
}
}
using pg8::Unit;
typedef f32x4 AccT[2][2][4][2];

struct EpiAda {
    static constexpr bool PERM = false;
    float* mod; const float* bias;
    __device__ __forceinline__ void operator()(const AccT& acc, const Unit& u, int wr, int wc, int fr, int fq) const {
        const int colb = u.pn * 256 + wc * 32 + 4 * fq;
#pragma unroll
        for (int ai = 0; ai < 2; ++ai)
#pragma unroll
            for (int m = 0; m < 4; ++m) {
                const int row = u.pm * 256 + ai * 128 + wr * 64 + m * 16 + fr;
                if (row < NSEQ) {
#pragma unroll
                    for (int bj = 0; bj < 2; ++bj)
#pragma unroll
                        for (int n = 0; n < 2; ++n) { const int c = colb + bj * 128 + n * 16; const f32x4 bv = *(const f32x4*)(bias + c);
                            *(f32x4*)(mod + (size_t)row * 24576 + c) = acc[ai][bj][m][n] + bv; }
                }
            }
    }
};
struct EpiBf16 {
    static constexpr bool PERM = true;
    bf16_t* O; int ldc;
    __device__ __forceinline__ void operator()(const AccT& acc, const Unit& u, int wr, int wc, int fr, int fq) const {
        const int col0 = u.pn * 256 + wc * 32 + 8 * fq;
#pragma unroll
        for (int ai = 0; ai < 2; ++ai)
#pragma unroll
            for (int m = 0; m < 4; ++m) { bf16_t* rowp = O + (size_t)(u.pm * 256 + ai * 128 + wr * 64 + m * 16 + fr) * ldc + col0;
#pragma unroll
                for (int bj = 0; bj < 2; ++bj) { const f32x4 v0 = acc[ai][bj][m][0], v1 = acc[ai][bj][m][1];
                    u32x4 w; w.x = cvt_pk_bf16(v0[0], v0[1]); w.y = cvt_pk_bf16(v0[2], v0[3]); w.z = cvt_pk_bf16(v1[0], v1[1]); w.w = cvt_pk_bf16(v1[2], v1[3]);
                    *(u32x4*)(rowp + bj * 128) = w; } }
    }
};
struct EpiGlu {
    static constexpr bool PERM = true;
    const bf16_t* yg; bf16_t* mix; const float* bias;
    __device__ __forceinline__ void operator()(const AccT& acc, const Unit& u, int wr, int wc, int fr, int fq) const {
        const int col0 = u.pn * 256 + wc * 32 + 8 * fq;
#pragma unroll
        for (int ai = 0; ai < 2; ++ai)
#pragma unroll
            for (int m = 0; m < 4; ++m) { const size_t row = (size_t)(u.pm * 256 + ai * 128 + wr * 64 + m * 16 + fr);
#pragma unroll
                for (int bj = 0; bj < 2; ++bj) { const int c = col0 + bj * 128;
                    const f32x4 v0 = acc[ai][bj][m][0] + *(const f32x4*)(bias + c), v1 = acc[ai][bj][m][1] + *(const f32x4*)(bias + c + 4);
                    const u32x4 y = *(const u32x4*)(yg + row * 1024 + c);
                    u32x4 w;
                    w.x = cvt_pk_bf16(bflo(y.x) * sigmoidf_(v0[0]), bfhi(y.x) * sigmoidf_(v0[1]));
                    w.y = cvt_pk_bf16(bflo(y.y) * sigmoidf_(v0[2]), bfhi(y.y) * sigmoidf_(v0[3]));
                    w.z = cvt_pk_bf16(bflo(y.z) * sigmoidf_(v1[0]), bfhi(y.z) * sigmoidf_(v1[1]));
                    w.w = cvt_pk_bf16(bflo(y.w) * sigmoidf_(v1[2]), bfhi(y.w) * sigmoidf_(v1[3]));
                    *(u32x4*)(mix + row * 2048 + 1024 + c) = w; } }
    }
};
struct EpiResid {
    static constexpr bool PERM = false;
    const float* xp; const float* xs; float* xout; const float* gate;
    float* part;
    __device__ __forceinline__ void operator()(const AccT& acc, const Unit& u, int wr, int wc, int fr, int fq) const {
        const int colb = u.pn * 256 + wc * 32 + 4 * fq;
        if (u.ks >= 0) {
#pragma unroll
            for (int ai = 0; ai < 2; ++ai)
#pragma unroll
                for (int m = 0; m < 4; ++m) { bf16_t* pr = (bf16_t*)part + ((size_t)u.ks * 1024 + (size_t)((u.pm - 32) * 256 + ai * 128 + wr * 64 + m * 16 + fr)) * DM;
#pragma unroll
                    for (int bj = 0; bj < 2; ++bj)
#pragma unroll
                        for (int n = 0; n < 2; ++n) { const f32x4 v = acc[ai][bj][m][n]; u32x2 o = {cvt_pk_bf16(v[0], v[1]), cvt_pk_bf16(v[2], v[3])}; *(u32x2*)(pr + colb + bj * 128 + n * 16) = o; } }
            return;
        }
#pragma unroll
        for (int ai = 0; ai < 2; ++ai)
#pragma unroll
            for (int m = 0; m < 4; ++m) {
                const int row = u.pm * 256 + ai * 128 + wr * 64 + m * 16 + fr;
                const float* xr = row < NPROMPT ? xp + (size_t)row * DM : xs + (size_t)(row - NPROMPT) * DM;
                const float* gr = gate + (size_t)row_seq(row) * 24576;
#pragma unroll
                for (int bj = 0; bj < 2; ++bj)
#pragma unroll
                    for (int n = 0; n < 2; ++n) { const int c = colb + bj * 128 + n * 16;
                        *(f32x4*)(xout + (size_t)row * DM + c) = *(const f32x4*)(xr + c) + *(const f32x4*)(gr + c) * acc[ai][bj][m][n]; }
            }
    }
};
struct EpiUpPart {
    static constexpr bool PERM = true;
    bf16_t* upart;
    __device__ __forceinline__ void operator()(const AccT& acc, const Unit& u, int wr, int wc, int fr, int fq) const {
        const int tr = u.pm == 35 ? u.pn : 44 + (u.pn - 40);
        bf16_t* tb = upart + ((size_t)u.ks * 48 + tr) * 65536 + wc * 32 + 8 * fq;
#pragma unroll
        for (int ai = 0; ai < 2; ++ai)
#pragma unroll
            for (int m = 0; m < 4; ++m)
#pragma unroll
                for (int bj = 0; bj < 2; ++bj) { const f32x4 v0 = acc[ai][bj][m][0], v1 = acc[ai][bj][m][1];
                    u32x4 w4; w4.x = cvt_pk_bf16(v0[0], v0[1]); w4.y = cvt_pk_bf16(v0[2], v0[3]); w4.z = cvt_pk_bf16(v1[0], v1[1]); w4.w = cvt_pk_bf16(v1[2], v1[3]);
                    *(u32x4*)(tb + (size_t)(ai * 128 + wr * 64 + m * 16 + fr) * 256 + bj * 128) = w4; }
    }
};
struct EpiSwiglu {
    static constexpr bool PERM = true;
    bf16_t* hh;
    __device__ __forceinline__ void operator()(const AccT& acc, const Unit& u, int wr, int wc, int fr, int fq) const {
        const int col0 = u.pn * 128 + wc * 32 + 8 * fq;
#pragma unroll
        for (int ai = 0; ai < 2; ++ai)
#pragma unroll
            for (int m = 0; m < 4; ++m) { const size_t row = (size_t)(u.pm * 256 + ai * 128 + wr * 64 + m * 16 + fr);
                const f32x4 a0 = acc[ai][0][m][0], a1 = acc[ai][0][m][1], b0 = acc[ai][1][m][0], b1 = acc[ai][1][m][1];
                u32x4 w;
                w.x = cvt_pk_bf16(siluf_(a0[0]) * b0[0], siluf_(a0[1]) * b0[1]); w.y = cvt_pk_bf16(siluf_(a0[2]) * b0[2], siluf_(a0[3]) * b0[3]);
                w.z = cvt_pk_bf16(siluf_(a1[0]) * b1[0], siluf_(a1[1]) * b1[1]); w.w = cvt_pk_bf16(siluf_(a1[2]) * b1[2], siluf_(a1[3]) * b1[3]);
                *(u32x4*)(hh + row * DFF + col0) = w; }
    }
};

__device__ __forceinline__ void tr_item(LAS float* tile, const float* WA, const float* WB, int ldw, bf16_t* WT  , int K) {
    const int tid = threadIdx.x;
    const int col = tid & 255, rh = tid >> 8;
    const float* src = (col < 128 ? WA + col : WB + (col - 128)) + (size_t)rh * ldw;
    float v[32];
#pragma unroll
    for (int i = 0; i < 32; ++i) v[i] = __builtin_nontemporal_load(src + (size_t)(2 * i) * ldw);
#pragma unroll
    for (int i = 0; i < 32; ++i) tile[(2 * i + rh) * 257 + col] = v[i];
    __syncthreads();
#pragma unroll
    for (int i = 0; i < 4; ++i) { const int c = tid + 512 * i, n = c >> 3, kc = c & 7; const LAS float* s = tile + (kc * 8) * 257 + n;
        u32x4 o; o.x = cvt_pk_bf16(s[0], s[257]); o.y = cvt_pk_bf16(s[2 * 257], s[3 * 257]); o.z = cvt_pk_bf16(s[4 * 257], s[5 * 257]); o.w = cvt_pk_bf16(s[6 * 257], s[7 * 257]);
        *(u32x4*)(WT + (size_t)n * K + kc * 8) = o; }
    __syncthreads();
}
constexpr int CONV_EARLY = 4 * 32 * 24 + 32 * 16;
constexpr int CONV_ALL = 4 * 32 * 24 + 32 * 16 + 16 * 4 + 32 * 8 + 2 * 32 * 44 + 2 * 88 * 8 + 32 * 24 + 32 * 8;
__device__ __forceinline__ void conv_items(LAS unsigned char* lds, const Params& P, int it0, int it1, int b, int G) {
    LAS float* tile = (LAS float*)lds;
    constexpr int N_ADA = 32 * 24, N_ABIN = 32 * 16, N_GLU = 16 * 4, N_SQ = 32 * 8, N_F13 = 32 * 44, N_F2 = 88 * 8, N_MLIN = 32 * 24;
    constexpr int NITEMS = 4 * N_ADA + N_ABIN + N_GLU + N_SQ + 2 * N_F13 + 2 * N_F2 + N_MLIN + N_SQ;
    static_assert(NITEMS == CONV_ALL, "item count");
    for (int it = it0 + b; it < it1; it += G) {
        int r = it;
        if (r < 4 * N_ADA) { const int a = r / N_ADA; r -= a * N_ADA; const int kt = r / 24, ntl = r % 24;
            const float* W = a == 0 ? P.in[I_ABADAW] : (a == 1 ? P.in[I_FADAW] : (a == 2 ? P.in[I_MLADAW] : P.in[I_FADAW] + (size_t)DM * 6144));
            const float* s = W + (size_t)(kt * 64) * 6144 + ntl * 256;
            tr_item(tile, s, s + 128, 6144, (bf16_t*)(P.ws + OFF_WADA) + (size_t)(a * 6144 + ntl * 256) * DM + kt * 64, DM); continue; }
        r -= 4 * N_ADA;
        if (r < N_ABIN) { const int kt = r / 16, ntl = r % 16; const int c0 = ntl * 256 + (ntl >= 12 ? 16 : 0);
            const float* s = P.in[I_ABWIN] + (size_t)(kt * 64) * 4112 + c0;
            tr_item(tile, s, s + 128, 4112, (bf16_t*)(P.ws + OFF_WABIN) + (size_t)(ntl * 256) * DM + kt * 64, DM); continue; }
        r -= N_ABIN;
        if (r < N_GLU) { const int kt = r / 4, ntl = r % 4; const float* s = P.in[I_S5WGLU] + (size_t)(kt * 64) * 1024 + ntl * 256;
            tr_item(tile, s, s + 128, 1024, (bf16_t*)(P.ws + OFF_WGLU) + (size_t)(ntl * 256) * 1024 + kt * 64, 1024); continue; }
        r -= N_GLU;
        if (r < N_SQ) { const int kt = r / 8, ntl = r % 8; const float* s = P.in[I_ABWOUT] + (size_t)(kt * 64) * DM + ntl * 256;
            tr_item(tile, s, s + 128, DM, (bf16_t*)(P.ws + OFF_WABOUT) + (size_t)(ntl * 256) * DM + kt * 64, DM); continue; }
        r -= N_SQ;
        if (r < 2 * N_F13) { const int l = r / N_F13; r -= l * N_F13; const int kt = r / 44, ntl = r % 44;
            const float* sa = P.in[I_FW1] + (size_t)l * DM * DFF + (size_t)(kt * 64) * DFF + ntl * 128;
            const float* sb = P.in[I_FW3] + (size_t)l * DM * DFF + (size_t)(kt * 64) * DFF + ntl * 128;
            tr_item(tile, sa, sb, DFF, (bf16_t*)(P.ws + OFF_WF13) + (size_t)l * 11264 * DM + (size_t)(ntl * 256) * DM + kt * 64, DM); continue; }
        r -= 2 * N_F13;
        if (r < 2 * N_F2) { const int l = r / N_F2; r -= l * N_F2; const int kt = r / 8, ntl = r % 8;
            const float* s = P.in[I_FW2] + (size_t)l * DFF * DM + (size_t)(kt * 64) * DM + ntl * 256;
            tr_item(tile, s, s + 128, DM, (bf16_t*)(P.ws + OFF_WF2) + (size_t)l * DM * DFF + (size_t)(ntl * 256) * DFF + kt * 64, DFF); continue; }
        r -= 2 * N_F2;
        if (r < N_MLIN) { const int kt = r / 24, ntl = r % 24; const float* s = P.in[I_MLWIN] + (size_t)(kt * 64) * 6152 + ntl * 256;
            tr_item(tile, s, s + 128, 6152, (bf16_t*)(P.ws + OFF_WMLIN) + (size_t)(ntl * 256) * DM + kt * 64, DM); continue; }
        r -= N_MLIN;
        { const int kt = r / 8, ntl = r % 8; const float* s = P.in[I_MLWOUT] + (size_t)(kt * 64) * DM + ntl * 256;
            tr_item(tile, s, s + 128, DM, (bf16_t*)(P.ws + OFF_WMLOUT) + (size_t)(ntl * 256) * DM + kt * 64, DM); }
    }
}
__device__ __forceinline__ void p0_prologue(LAS unsigned char* lds, const Params& P) {
    const int G = gridDim.x, b = blockIdx.x;
    conv_items(lds, P, 0, 768, b, G);
    const int gt = b * NTHREADS + threadIdx.x, GT = G * NTHREADS;
    bf16_t* cs = (bf16_t*)(P.ws + OFF_CS);
    for (int i = gt; i < 256 * DM; i += GT) { const int row = i >> 11, c = i & 2047; float v = 0.f;
        if (row < 4) v = siluf_(P.in[I_CP][row * DM + c]); else if (row < NSEQ) v = siluf_(P.in[I_CS][(row - 4) * DM + c]);
        cs[i] = f2bf(v); }
    float* wglr = (float*)(P.ws + OFF_WGLR);
    for (int i = gt; i < 16 * DM; i += GT) { const int r = i >> 11, k = i & 2047; wglr[i] = P.in[I_ABWIN][(size_t)k * 4112 + 3072 + r]; }
    float* bada = (float*)(P.ws + OFF_BADA);
    for (int i = gt; i < 24576; i += GT) { const int a = i / 6144, c = i - a * 6144;
        bada[i] = a == 0 ? P.in[I_ABADAB][c] : (a == 1 ? P.in[I_FADAB][c] : (a == 2 ? P.in[I_MLADAB][c] : P.in[I_FADAB][6144 + c])); }
    float* wmlg = (float*)(P.ws + OFF_WMLG);
    for (int i = gt; i < 8 * DM; i += GT) { const int r = i >> 11, k = i & 2047; wmlg[i] = P.in[I_MLWIN][(size_t)k * 6152 + 6144 + r]; }
}

template <int MODE>
__device__ __forceinline__ void norm_phase(LAS unsigned char* lds, const Params& P, const float* norm_g, int ada_idx, int fix_idx) {
    const int tid = threadIdx.x, lane = tid & 63, w = tid >> 6;
    LAS float* wl = (LAS float*)lds;
    if (MODE == 0) { const f32x4* s = (const f32x4*)(P.ws + OFF_WGLR); for (int i = tid; i < 16 * DM / 4; i += NTHREADS) ((LAS f32x4*)wl)[i] = s[i]; __syncthreads(); }
    if (MODE == 2) { const f32x4* s = (const f32x4*)(P.ws + OFF_WMLG); for (int i = tid; i < 8 * DM / 4; i += NTHREADS) ((LAS f32x4*)wl)[i] = s[i]; __syncthreads(); }
    const float* mod = (const float*)(P.ws + OFF_MOD);
    float* xcur = (float*)(P.ws + OFF_XCUR);
    bf16_t* hA = (bf16_t*)(P.ws + OFF_HA);
    for (int row = blockIdx.x * 8 + w; row < MROWS; row += gridDim.x * 8) {
        const float* xr = MODE == 0 ? (row < NPROMPT ? P.in[I_XP] + (size_t)row * DM : P.in[I_XS] + (size_t)(row - NPROMPT) * DM) : xcur + (size_t)row * DM;
        f32x4 v[8]; float ss = 0.f;
        if (MODE != 0 && fix_idx >= 0 && row >= NPROMPT && gridDim.x == 256) {
            const float* base = fix_idx == 0 ? P.in[I_XS] + (size_t)(row - NPROMPT) * DM : xr;
            const float* gr = mod + (size_t)row_seq(row) * 24576 + fix_idx * 6144 + 4096;
            const bf16_t* pr = (const bf16_t*)(P.ws + OFF_PART) + (size_t)(row - NPROMPT) * DM;
#pragma unroll
            for (int j = 0; j < 8; ++j) { f32x4 a = {0.f, 0.f, 0.f, 0.f};
#pragma unroll
                for (int ks = 0; ks < 8; ++ks) { const u32x2 pv = ((const u32x2*)(pr + (size_t)ks * 1024 * DM))[lane + 64 * j]; a[0] += bflo(pv.x); a[1] += bfhi(pv.x); a[2] += bflo(pv.y); a[3] += bfhi(pv.y); }
                v[j] = ((const f32x4*)base)[lane + 64 * j] + ((const f32x4*)gr)[lane + 64 * j] * a;
                ((f32x4*)(xcur + (size_t)row * DM))[lane + 64 * j] = v[j]; }
        } else {
#pragma unroll
            for (int j = 0; j < 8; ++j) v[j] = ((const f32x4*)xr)[lane + 64 * j];
        }
#pragma unroll
        for (int j = 0; j < 8; ++j) { ss += (v[j][0] * v[j][0] + v[j][1] * v[j][1]) + (v[j][2] * v[j][2] + v[j][3] * v[j][3]); }
        const float rstd = rsqrtf(wave_sum(ss) * (1.f / DM) + EPS);
        if (MODE == 3) {
            float* o = row < NPROMPT ? P.out + O_YP + (size_t)row * DM : P.out + O_YS + (size_t)(row - NPROMPT) * DM;
#pragma unroll
            for (int j = 0; j < 8; ++j) { const f32x4 g = ((const f32x4*)norm_g)[lane + 64 * j]; ((f32x4*)o)[lane + 64 * j] = v[j] * rstd * g; }
            continue;
        }
        const float* mr = mod + (size_t)row_seq(row) * 24576 + ada_idx * 6144;
#pragma unroll
        for (int j = 0; j < 8; ++j) { const f32x4 g = ((const f32x4*)norm_g)[lane + 64 * j], sh = ((const f32x4*)mr)[lane + 64 * j], sc = ((const f32x4*)(mr + DM))[lane + 64 * j];
            v[j] = v[j] * rstd * g * (sc + 1.f) + sh;
            u32x2 o; o.x = cvt_pk_bf16(v[j][0], v[j][1]); o.y = cvt_pk_bf16(v[j][2], v[j][3]);
            ((u32x2*)(hA + (size_t)row * DM))[lane + 64 * j] = o; }
        if (MODE == 0) {
            LAS float* GL = (LAS float*)(lds + 131072) + w * 16;
#pragma unroll 1
            for (int r = 0; r < 16; ++r) { float a = 0.f;
#pragma unroll
                for (int j = 0; j < 8; ++j) { const f32x4 ww = ((const LAS f32x4*)(wl + r * DM))[lane + 64 * j]; a += (v[j][0] * ww[0] + v[j][1] * ww[1]) + (v[j][2] * ww[2] + v[j][3] * ww[3]); }
                a = wave_sum(a); if (lane == 0) GL[r] = a; }
            LDS_FENCE();
            float g[16];
#pragma unroll
            for (int r = 0; r < 16; ++r) g[r] = GL[r];
            float* la = (float*)(P.ws + OFF_LA) + (size_t)row * 512;
#pragma unroll 2
            for (int i = 0; i < 8; ++i) { const int n = lane + 64 * i; float a = P.in[I_GLABG][n];
#pragma unroll
                for (int r = 0; r < 16; ++r) a += g[r] * P.in[I_GLAWG][r * 512 + n];
                la[n] = logsigmoidf_(a) * (1.f / 16.f); }
            LDS_FENCE();
        }
        if (MODE == 2) {
            float g[8];
#pragma unroll
            for (int r = 0; r < 8; ++r) { float a = 0.f;
#pragma unroll
                for (int j = 0; j < 8; ++j) { const f32x4 ww = ((const LAS f32x4*)(wl + r * DM))[lane + 64 * j]; a += (v[j][0] * ww[0] + v[j][1] * ww[1]) + (v[j][2] * ww[2] + v[j][3] * ww[3]); }
                g[r] = wave_sum(a); }
            if (lane < 8) { float val = 0.f;
#pragma unroll
                for (int r = 0; r < 8; ++r) if (lane == r) val = g[r];
                val = lane < 4 ? val + P.in[I_MLBI][lane] : logsigmoidf_(val + P.in[I_MLBF][lane - 4]);
                ((float*)(P.ws + OFF_GT))[(size_t)row * 8 + lane] = val; }
        }
    }
    if (MODE == 0 || MODE == 2) __syncthreads();
}

template <int L>
__device__ __forceinline__ void gla_unit(LAS unsigned char* lds, const Params& P, int head, int vs, int row0, int nchunks, int nvalid, const float* s_in, float* s_out) {
    constexpr int TPT = L / 4, NTT = L / 16, NKS = L / 32, LP = L + 8, QP = 136;
    LAS bf16_t* QE = (LAS bf16_t*)lds;
    LAS bf16_t* KE = QE + L * QP;
    LAS bf16_t* K2T = KE + L * QP;
    LAS bf16_t* VT = K2T + 128 * LP;
    LAS bf16_t* ATT = VT + 128 * LP;
    LAS float* QS = (LAS float*)(ATT + L * LP);
    LAS float* DEC = QS + 512;
    const int tid = threadIdx.x, lane = tid & 63, w = tid >> 6, quad = lane >> 4, l16 = lane & 15;
    const int d = tid & 127, tq = tid >> 7;
    const bf16_t* z = (const bf16_t*)(P.ws + OFF_Z);
    const float* la = (const float*)(P.ws + OFF_LA);
    float* obuf = (float*)(P.ws + OFF_OBUF);
    const int vcol = vs * 128 + w * 16;
    const float scale = 0.08838834764831845f;
    float lav[TPT]; unsigned qv[TPT], kv[TPT], vv[TPT];
#define GLA_LOAD(rr) do { _Pragma("unroll") for (int i = 0; i < TPT; ++i) { const int t = tq * TPT + i; lav[i] = 0.f; qv[i] = 0; kv[i] = 0; vv[i] = 0; \
            if (t < nvalid) { lav[i] = la[(size_t)((rr) + t) * 512 + head * 128 + d]; const bf16_t* zr = z + (size_t)((rr) + t) * 4096; \
                qv[i] = zr[head * 128 + d]; kv[i] = zr[512 + head * 128 + d]; vv[i] = zr[1024 + head * 256 + vs * 128 + d]; } } } while (0)
    GLA_LOAD(row0);
    f32x4 S[8];
#pragma unroll
    for (int dt = 0; dt < 8; ++dt) {
        if (s_in) {
#pragma unroll
            for (int j = 0; j < 4; ++j) S[dt][j] = __builtin_nontemporal_load(s_in + (size_t)(dt * 16 + quad * 4 + j) * 256 + vcol + l16);
        } else S[dt] = (f32x4){0.f, 0.f, 0.f, 0.f};
    }
    for (int c = 0; c < nchunks; ++c) {
        const int r0 = row0 + c * L;
        float b[TPT]; float run = 0.f;
#pragma unroll
        for (int i = 0; i < TPT; ++i) { run += lav[i]; b[i] = run; }
        QS[tq * 128 + d] = run;
        __syncthreads();
        float pre = 0.f, tot = 0.f;
#pragma unroll
        for (int q = 0; q < 4; ++q) { const float x = QS[q * 128 + d]; tot += x; if (q < tq) pre += x; }
        unsigned k2[TPT]; const float etot = __expf(tot);
#pragma unroll
        for (int i = 0; i < TPT; ++i) { const int t = tq * TPT + i; const float bb = b[i] + pre; const float q = bf2f(qv[i]), k = bf2f(kv[i]); const float kem = k * __expf(-bb);
            QE[t * QP + d] = f2bf(q * scale * __expf(bb)); KE[t * QP + d] = f2bf(kem); k2[i] = f2bf(kem * etot); }
#pragma unroll
        for (int i = 0; i < TPT; i += 8) {
            u32x4 o = {k2[i] | (k2[i + 1] << 16), k2[i + 2] | (k2[i + 3] << 16), k2[i + 4] | (k2[i + 5] << 16), k2[i + 6] | (k2[i + 7] << 16)};
            *(LAS u32x4*)(K2T + d * LP + tq * TPT + i) = o;
            u32x4 o2 = {vv[i] | (vv[i + 1] << 16), vv[i + 2] | (vv[i + 3] << 16), vv[i + 4] | (vv[i + 5] << 16), vv[i + 6] | (vv[i + 7] << 16)};
            *(LAS u32x4*)(VT + d * LP + tq * TPT + i) = o2; }
        if (c + 1 < nchunks) GLA_LOAD(r0 + L);
        if (tq == 0) DEC[d] = etot;
        __syncthreads();
        constexpr int NTASK = NTT == 4 ? 12 : 4;
        for (int idx = w; idx < NTASK; idx += 8) {
            int tt, st; if (NTT == 4) { if (idx < 2) { tt = 0; st = idx; } else if (idx < 4) { tt = 1; st = idx - 2; } else if (idx < 8) { tt = 2; st = idx - 4; } else { tt = 3; st = idx - 8; } } else { tt = idx >> 1; st = idx & 1; }
            f32x4 acc = {0.f, 0.f, 0.f, 0.f};
            if (st <= tt) {
#pragma unroll
                for (int ks = 0; ks < 4; ++ks) { const bf16x8 A = *(const LAS bf16x8*)(KE + (st * 16 + l16) * QP + ks * 32 + quad * 8), B = *(const LAS bf16x8*)(QE + (tt * 16 + l16) * QP + ks * 32 + quad * 8);
                    acc = MFMA16(A, B, acc); }
                const int t = tt * 16 + l16;
#pragma unroll
                for (int j = 0; j < 4; ++j) if (st * 16 + quad * 4 + j > t) acc[j] = 0.f;
            }
            u32x2 o = {cvt_pk_bf16(acc[0], acc[1]), cvt_pk_bf16(acc[2], acc[3])};
            *(LAS u32x2*)(ATT + (tt * 16 + l16) * LP + st * 16 + quad * 4) = o;
        }
        __syncthreads();
        bf16x8 sa[4];
#pragma unroll
        for (int ks = 0; ks < 4; ++ks) sa[ks] = mk8(cvt_pk_bf16(S[2 * ks][0], S[2 * ks][1]), cvt_pk_bf16(S[2 * ks][2], S[2 * ks][3]), cvt_pk_bf16(S[2 * ks + 1][0], S[2 * ks + 1][1]), cvt_pk_bf16(S[2 * ks + 1][2], S[2 * ks + 1][3]));
#pragma unroll
        for (int tt = 0; tt < NTT; ++tt) {
            const int t = tt * 16 + l16; f32x4 acc = {0.f, 0.f, 0.f, 0.f};
#pragma unroll
            for (int ks = 0; ks < 4; ++ks) { const u32x2 lo = *(const LAS u32x2*)(QE + t * QP + ks * 32 + quad * 4), hi = *(const LAS u32x2*)(QE + t * QP + ks * 32 + 16 + quad * 4);
                acc = MFMA16(sa[ks], mk8(lo.x, lo.y, hi.x, hi.y), acc); }
#pragma unroll
            for (int k2s = 0; k2s < NKS; ++k2s) if (2 * k2s <= tt) { const bf16x8 A = *(const LAS bf16x8*)(VT + (w * 16 + l16) * LP + k2s * 32 + quad * 8), B = *(const LAS bf16x8*)(ATT + t * LP + k2s * 32 + quad * 8);
                acc = MFMA16(A, B, acc); }
            if (t < nvalid) *(f32x4*)(obuf + (size_t)(r0 + t) * 2048 + head * 256 + vcol + quad * 4) = acc;
        }
#pragma unroll
        for (int dt = 0; dt < 8; ++dt) { const f32x4 dc = *(const LAS f32x4*)(DEC + dt * 16 + quad * 4); f32x4 acc = S[dt] * dc;
#pragma unroll
            for (int k2s = 0; k2s < NKS; ++k2s) { const bf16x8 A = *(const LAS bf16x8*)(K2T + (dt * 16 + l16) * LP + k2s * 32 + quad * 8), B = *(const LAS bf16x8*)(VT + (w * 16 + l16) * LP + k2s * 32 + quad * 8);
                acc = MFMA16(A, B, acc); }
            S[dt] = acc; }
        __syncthreads();
    }
#pragma unroll
    for (int dt = 0; dt < 8; ++dt)
#pragma unroll
        for (int j = 0; j < 4; ++j) __builtin_nontemporal_store(S[dt][j], s_out + (size_t)(dt * 16 + quad * 4 + j) * 256 + vcol + l16);
}

__device__ __forceinline__ void s5_wave(LAS unsigned char* wl, const Params& P, int g, int row0_, int nblocks, int nvalid, const float* h0re_, const float* h0im_, float* ore_, float* oim_, int nseq = 1, int rstride = 0, int sstride = 0) {
    LAS float* BU = (LAS float*)wl;
    LAS bf16_t* HS = (LAS bf16_t*)(wl + 8448);
    const int lane = threadIdx.x & 63, quad = lane >> 4, l16 = lane & 15;
    const float dt = __expf(P.in[I_S5LDT][g]);
    float a_re, a_im;
    { const float lr = P.in[I_S5LRE][g * 64 + lane], li = P.in[I_S5LIM][g * 64 + lane]; const float mag = expf(lr * dt); float sn, cn; sincosf(li * dt, &sn, &cn); a_re = mag * cn; a_im = mag * sn; }
    bf16x8 bfr[8];
#pragma unroll
    for (int nt = 0; nt < 8; ++nt) {
        const int p = nt * 8 + (l16 >> 1); const bool isim = (l16 & 1) != 0;
        const float lr = P.in[I_S5LRE][g * 64 + p], li = P.in[I_S5LIM][g * 64 + p]; const float mag = expf(lr * dt); float sn, cn; sincosf(li * dt, &sn, &cn);
        const float ar = mag * cn, ai = mag * sn, den = lr * lr + li * li;
        const float fr = ((ar - 1.f) * lr + ai * li) / den, fi = (ai * lr - (ar - 1.f) * li) / den;
        unsigned pk[4] = {0, 0, 0, 0};
        if (quad < 2) {
            const float* br = P.in[I_S5BRE] + (size_t)(g * 64 + p) * 16 + quad * 8; const float* bi = P.in[I_S5BIM] + (size_t)(g * 64 + p) * 16 + quad * 8;
#pragma unroll
            for (int j = 0; j < 4; ++j) { const float r0 = br[2 * j], r1 = br[2 * j + 1], i0 = bi[2 * j], i1 = bi[2 * j + 1];
                pk[j] = isim ? cvt_pk_bf16(fr * i0 + fi * r0, fr * i1 + fi * r1) : cvt_pk_bf16(fr * r0 - fi * i0, fr * r1 - fi * i1); }
        }
        bfr[nt] = mk8(pk[0], pk[1], pk[2], pk[3]);
    }
    bf16x8 cfr[4];
#pragma unroll
    for (int ks = 0; ks < 4; ++ks) { const int p0 = ks * 16 + quad * 4; const float* cr = P.in[I_S5CRE] + (size_t)(g * 16 + l16) * 64 + p0; const float* ci = P.in[I_S5CIM] + (size_t)(g * 16 + l16) * 64 + p0;
        cfr[ks] = mk8(cvt_pk_bf16(cr[0], -ci[0]), cvt_pk_bf16(cr[1], -ci[1]), cvt_pk_bf16(cr[2], -ci[2]), cvt_pk_bf16(cr[3], -ci[3])); }
    const float dsk = P.in[I_S5D][g * 16 + l16];
    const bf16_t* z = (const bf16_t*)(P.ws + OFF_Z);
    bf16_t* yg = (bf16_t*)(P.ws + OFF_YG);
    for (int si = 0; si < nseq; ++si) {
    const int row0 = row0_ + si * rstride; float* ore = ore_ + (size_t)si * sstride; float* oim = oim_ + (size_t)si * sstride;
    float hr = h0re_ ? h0re_[(size_t)si * sstride + lane] : 0.f, hi = h0im_ ? h0im_[(size_t)si * sstride + lane] : 0.f;
    bf16x8 Aq[4]; unsigned uq[4][4];
#define S5_LOADG(b0) do { _Pragma("unroll") for (int q = 0; q < 4; ++q) if ((b0) + q < nblocks) { const int rr = row0 + ((b0) + q) * 16; \
            Aq[q] = mk8(0, 0, 0, 0); if (quad < 2 && l16 < nvalid) Aq[q] = *(const bf16x8*)(z + (size_t)(rr + l16) * 4096 + 3072 + g * 16 + quad * 8); \
            _Pragma("unroll") for (int j = 0; j < 4; ++j) uq[q][j] = (quad * 4 + j < nvalid) ? (unsigned)z[(size_t)(rr + quad * 4 + j) * 4096 + 3072 + g * 16 + l16] : 0u; } } while (0)
    S5_LOADG(0);
    for (int blk0 = 0; blk0 < nblocks; blk0 += 4) {
        bf16x8 Ac[4]; unsigned uc[4][4];
#pragma unroll
        for (int q = 0; q < 4; ++q) { Ac[q] = Aq[q];
#pragma unroll
            for (int j = 0; j < 4; ++j) uc[q][j] = uq[q][j]; }
        if (blk0 + 4 < nblocks) S5_LOADG(blk0 + 4);
#pragma unroll
        for (int q = 0; q < 4; ++q) if (blk0 + q < nblocks) {
            const int r0 = row0 + (blk0 + q) * 16;
#pragma unroll
            for (int nt = 0; nt < 8; ++nt) { const f32x4 dd = MFMA16(Ac[q], bfr[nt], ((f32x4){0.f, 0.f, 0.f, 0.f}));
#pragma unroll
                for (int j = 0; j < 4; ++j) BU[(quad * 4 + j) * 132 + nt * 16 + l16] = dd[j]; }
            LDS_FENCE();
#pragma unroll
            for (int t = 0; t < 16; ++t) if (t < nvalid) { const f32x2 bb = *(const LAS f32x2*)(BU + t * 132 + 2 * lane);
                const float nr = a_re * hr - a_im * hi + bb[0], ni = a_re * hi + a_im * hr + bb[1]; hr = nr; hi = ni;
                *(LAS unsigned*)(HS + t * 136 + 2 * lane) = cvt_pk_bf16(hr, hi); }
            LDS_FENCE();
            f32x4 acc = {0.f, 0.f, 0.f, 0.f};
#pragma unroll
            for (int ks = 0; ks < 4; ++ks) { const bf16x8 Ah = *(const LAS bf16x8*)(HS + l16 * 136 + ks * 32 + quad * 8); acc = MFMA16(Ah, cfr[ks], acc); }
#pragma unroll
            for (int j = 0; j < 4; ++j) if (quad * 4 + j < nvalid) { const float y = acc[j] + dsk * bf2f(uc[q][j]); yg[(size_t)(r0 + quad * 4 + j) * 1024 + g * 16 + l16] = f2bf(gelu_tanh(y)); }
            LDS_FENCE();
        }
    }
    ore[lane] = hr; oim[lane] = hi;
    }
#undef S5_LOADG
}

template <int L>
__device__ __forceinline__ void ml_unit(LAS unsigned char* lds, const Params& P, int head, int vs, int row0, int nchunks, int nvalid,
                                        const float* c_in, const float* n_in, float m0, float* c_out, float* n_out, float* m_out) {
    constexpr int NTT = L / 16, NKS = L / 32, LP = L + 8, QP = 264, VQ = L / 4;
    LAS bf16_t* Q = (LAS bf16_t*)lds;
    LAS bf16_t* Kt = Q + L * QP;
    LAS bf16_t* KTS = Kt + L * QP;
    LAS bf16_t* VT = KTS + 256 * LP;
    LAS bf16_t* SW = VT + 128 * LP;
    LAS float* TB = (LAS float*)(SW + L * LP);
    LAS float* T_BTT = TB, *T_CS = TB + 64, *T_WS = TB + 128, *T_GI = TB + 192, *T_EMT = TB + 256, *T_NQ = TB + 320, *T_RS = TB + 384  , *T_N = TB + 640  ;
    const int tid = threadIdx.x, lane = tid & 63, w = tid >> 6, quad = lane >> 4, l16 = lane & 15;
    const bf16_t* z = (const bf16_t*)(P.ws + OFF_Z);
    const float* gt = (const float*)(P.ws + OFF_GT);
    float* obuf = (float*)(P.ws + OFF_OBUF);
    const int vcol = vs * 128 + w * 16;
    float nreg = 0.f; if (tid < 256) { nreg = n_in ? n_in[tid] : 0.f; T_N[tid] = nreg; }
    float m = m0;
    const int d2 = (tid & 127) * 2, tq = tid >> 7, vv_ = tid & 127;
    unsigned qv[VQ], kv[VQ], vv[VQ]; float fgn, ign;
#define ML_LOAD(rr) do { fgn = 0.f; ign = -1e30f; if (lane < L && lane < nvalid) { ign = gt[(size_t)((rr) + lane) * 8 + head]; fgn = gt[(size_t)((rr) + lane) * 8 + 4 + head]; } \
        _Pragma("unroll") for (int i = 0; i < VQ; ++i) { const int t = tq * VQ + i; qv[i] = 0; kv[i] = 0; vv[i] = 0; \
            if (t < nvalid) { const bf16_t* zr = z + (size_t)((rr) + t) * 6144; qv[i] = *(const unsigned*)(zr + head * 256 + d2); kv[i] = *(const unsigned*)(zr + 1024 + head * 256 + d2); \
                vv[i] = zr[2048 + head * 512 + vs * 128 + vv_]; } } } while (0)
    ML_LOAD(row0);
    f32x4 C[16];
#pragma unroll
    for (int dt = 0; dt < 16; ++dt) {
        if (c_in) C[dt] = __builtin_nontemporal_load((const f32x4*)(c_in + (size_t)(vcol + l16) * 256 + dt * 16 + quad * 4));
        else C[dt] = (f32x4){0.f, 0.f, 0.f, 0.f};
    }
    for (int c = 0; c < nchunks; ++c) {
        const int r0 = row0 + c * L;
        const float fg = fgn, ig = ign;
        float bcum = fg;
#pragma unroll
        for (int o = 1; o < 64; o <<= 1) { const float x = __shfl_up(bcum, o); if (lane >= o) bcum += x; }
        const float csv = ig - bcum; float pm = csv;
#pragma unroll
        for (int o = 1; o < 64; o <<= 1) { const float x = __shfl_up(pm, o); if (lane >= o) pm = fmaxf(pm, x); }
        const float blast = __shfl(bcum, L - 1), pmall = __shfl(pm, L - 1);
        const float mx = fmaxf(m, pm), mxall = fmaxf(m, pmall);
        const float decay = __expf(m - mxall);
        if (w == 0 && lane < L) { T_BTT[lane] = -mx; T_CS[lane] = csv; T_WS[lane] = __expf(csv - mxall); T_GI[lane] = __expf(m - mx); T_EMT[lane] = __expf(-(bcum + mx)); }
        m = blast + mxall;
        __syncthreads();
#pragma unroll
        for (int i = 0; i < VQ; i += 8) {
            unsigned k0[8], k1[8];
#pragma unroll
            for (int e = 0; e < 8; ++e) { const int t = tq * VQ + i + e; const float ka = bflo(kv[i + e]) * 0.0625f, kb = bfhi(kv[i + e]) * 0.0625f; const float wsv = T_WS[t];
                *(LAS unsigned*)(Q + t * QP + d2) = qv[i + e]; *(LAS unsigned*)(Kt + t * QP + d2) = cvt_pk_bf16(ka, kb); k0[e] = f2bf(ka * wsv); k1[e] = f2bf(kb * wsv); }
            u32x4 o0 = {k0[0] | (k0[1] << 16), k0[2] | (k0[3] << 16), k0[4] | (k0[5] << 16), k0[6] | (k0[7] << 16)};
            u32x4 o1 = {k1[0] | (k1[1] << 16), k1[2] | (k1[3] << 16), k1[4] | (k1[5] << 16), k1[6] | (k1[7] << 16)};
            *(LAS u32x4*)(KTS + d2 * LP + tq * VQ + i) = o0; *(LAS u32x4*)(KTS + (d2 + 1) * LP + tq * VQ + i) = o1;
            u32x4 o = {vv[i] | (vv[i + 1] << 16), vv[i + 2] | (vv[i + 3] << 16), vv[i + 4] | (vv[i + 5] << 16), vv[i + 6] | (vv[i + 7] << 16)};
            *(LAS u32x4*)(VT + vv_ * LP + tq * VQ + i) = o; }
        if (c + 1 < nchunks) ML_LOAD(r0 + L);
        __syncthreads();
        { constexpr int PARTS = 512 / L, DPER = 256 / PARTS; const int t = tid / PARTS, part = tid % PARTS; float a = 0.f;
#pragma unroll 8
          for (int e = 0; e < DPER; ++e) a += T_N[part * DPER + e] * bf2f(Q[t * QP + part * DPER + e]);
#pragma unroll
          for (int o = 1; o < PARTS; o <<= 1) a += __shfl_xor(a, o);
          if (part == 0) T_NQ[t] = a; }
        constexpr int NTASK = NTT == 4 ? 12 : 4;
        for (int idx = w; idx < NTASK; idx += 8) {
            int tt, st; if (NTT == 4) { if (idx < 2) { tt = 0; st = idx; } else if (idx < 4) { tt = 1; st = idx - 2; } else if (idx < 8) { tt = 2; st = idx - 4; } else { tt = 3; st = idx - 8; } } else { tt = idx >> 1; st = idx & 1; }
            f32x4 acc = {0.f, 0.f, 0.f, 0.f}; const int t = tt * 16 + l16;
            if (st <= tt) {
#pragma unroll
                for (int ks = 0; ks < 8; ++ks) { const bf16x8 A = *(const LAS bf16x8*)(Kt + (st * 16 + l16) * QP + ks * 32 + quad * 8), B = *(const LAS bf16x8*)(Q + t * QP + ks * 32 + quad * 8);
                    acc = MFMA16(A, B, acc); }
                const float btt = T_BTT[t]; const f32x4 cs4 = *(const LAS f32x4*)(T_CS + st * 16 + quad * 4);
#pragma unroll
                for (int j = 0; j < 4; ++j) acc[j] = (st * 16 + quad * 4 + j > t) ? 0.f : acc[j] * __expf(btt + cs4[j]);
                float rs = (acc[0] + acc[1]) + (acc[2] + acc[3]); rs += __shfl_xor(rs, 16); rs += __shfl_xor(rs, 32);
                if (quad == 0) T_RS[t * 4 + st] = rs;
            }
            u32x2 o = {cvt_pk_bf16(acc[0], acc[1]), cvt_pk_bf16(acc[2], acc[3])};
            *(LAS u32x2*)(SW + t * LP + st * 16 + quad * 4) = o;
        }
        __syncthreads();
#pragma unroll
        for (int tt = 0; tt < NTT; ++tt) {
            const int t = tt * 16 + l16; f32x4 acc = {0.f, 0.f, 0.f, 0.f};
#pragma unroll
            for (int ks = 0; ks < 8; ++ks) {
                const bf16x8 sa = mk8(cvt_pk_bf16(C[2 * ks][0], C[2 * ks][1]), cvt_pk_bf16(C[2 * ks][2], C[2 * ks][3]), cvt_pk_bf16(C[2 * ks + 1][0], C[2 * ks + 1][1]), cvt_pk_bf16(C[2 * ks + 1][2], C[2 * ks + 1][3]));
                const u32x2 lo = *(const LAS u32x2*)(Q + t * QP + ks * 32 + quad * 4), hi = *(const LAS u32x2*)(Q + t * QP + ks * 32 + 16 + quad * 4);
                acc = MFMA16(sa, mk8(lo.x, lo.y, hi.x, hi.y), acc); }
            const float gi = T_GI[t]; acc = acc * gi;
#pragma unroll
            for (int k2s = 0; k2s < NKS; ++k2s) if (2 * k2s <= tt) { const bf16x8 A = *(const LAS bf16x8*)(VT + (w * 16 + l16) * LP + k2s * 32 + quad * 8), B = *(const LAS bf16x8*)(SW + t * LP + k2s * 32 + quad * 8);
                acc = MFMA16(A, B, acc); }
            float den = gi * T_NQ[t];
#pragma unroll
            for (int st = 0; st < NTT; ++st) if (st <= tt) den += T_RS[t * 4 + st];
            const float rd = 1.f / fmaxf(fabsf(den), T_EMT[t]);
            if (t < nvalid) *(f32x4*)(obuf + (size_t)(r0 + t) * 2048 + head * 512 + vcol + quad * 4) = acc * rd;
        }
#pragma unroll
        for (int dt = 0; dt < 16; ++dt) { f32x4 acc = C[dt] * decay;
#pragma unroll
            for (int k2s = 0; k2s < NKS; ++k2s) { const bf16x8 A = *(const LAS bf16x8*)(KTS + (dt * 16 + l16) * LP + k2s * 32 + quad * 8), B = *(const LAS bf16x8*)(VT + (w * 16 + l16) * LP + k2s * 32 + quad * 8);
                acc = MFMA16(A, B, acc); }
            C[dt] = acc; }
        if (tid < 256) { float a = nreg * decay;
#pragma unroll 8
            for (int s = 0; s < L; ++s) a += T_WS[s] * bf2f(Kt[s * QP + tid]);
            nreg = a; }
        __syncthreads();
        if (tid < 256) T_N[tid] = nreg;
    }
#pragma unroll
    for (int dt = 0; dt < 16; ++dt) __builtin_nontemporal_store(C[dt], (f32x4*)(c_out + (size_t)(vcol + l16) * 256 + dt * 16 + quad * 4));
    if (vs == 0) { if (tid < 256) n_out[tid] = nreg; if (tid == 0) *m_out = m; }
    __syncthreads();
}


constexpr size_t MLB_STRIDE = 122880;
constexpr int MLB_KTS = 0, MLB_SW = 36864, MLB_VT = 46080, MLB_SC = 119808;
__device__ __forceinline__ unsigned char* ml_blob(const Params& P, int seq, int head, int c) { return P.ws + OFF_HH + (size_t)((seq * 4 + head) * 32 + c) * MLB_STRIDE; }

__device__ __forceinline__ void ml_prep(LAS unsigned char* lds, const Params& P, int seq, int head, int c) {
    constexpr int L = 64, QP = 264, LP = 72;
    LAS bf16_t* Q = (LAS bf16_t*)lds;
    LAS bf16_t* Kt = Q + L * QP;
    LAS float* TB = (LAS float*)(Kt + L * QP);
    LAS float* T_PM = TB, *T_CS = TB + 64, *T_RS = TB + 128, *T_KS = TB + 384;
    const int tid = threadIdx.x, lane = tid & 63, w = tid >> 6, quad = lane >> 4, l16 = lane & 15;
    const bf16_t* z = (const bf16_t*)(P.ws + OFF_Z);
    const float* gt = (const float*)(P.ws + OFF_GT);
    const int r0 = seq * 2048 + c * L;
    unsigned char* blob = ml_blob(P, seq, head, c);
    bf16_t* KTSg = (bf16_t*)(blob + MLB_KTS); bf16_t* SWg = (bf16_t*)(blob + MLB_SW); bf16_t* VTg = (bf16_t*)(blob + MLB_VT); float* SCg = (float*)(blob + MLB_SC);
    const float ig = gt[(size_t)(r0 + lane) * 8 + head], fg = gt[(size_t)(r0 + lane) * 8 + 4 + head];
    float bcum = fg;
#pragma unroll
    for (int o = 1; o < 64; o <<= 1) { const float x = __shfl_up(bcum, o); if (lane >= o) bcum += x; }
    const float csv = ig - bcum; float pm = csv;
#pragma unroll
    for (int o = 1; o < 64; o <<= 1) { const float x = __shfl_up(pm, o); if (lane >= o) pm = fmaxf(pm, x); }
    const float blast = __shfl(bcum, 63), pmall = __shfl(pm, 63);
    if (w == 0) { T_PM[lane] = pm; T_CS[lane] = csv; SCg[lane] = pm; SCg[64 + lane] = bcum; if (lane == 0) { SCg[448] = pmall; SCg[449] = blast; } }
    const int d2 = (tid & 127) * 2, tq = tid >> 7, vv_ = tid & 127;
    unsigned qv[16], kv[16];
#pragma unroll
    for (int i = 0; i < 16; ++i) { const bf16_t* zr = z + (size_t)(r0 + tq * 16 + i) * 6144; qv[i] = *(const unsigned*)(zr + head * 256 + d2); kv[i] = *(const unsigned*)(zr + 1024 + head * 256 + d2); }
    unsigned vvb[2][16];
#define MLP_VLOAD(buf, vsl_) do { _Pragma("unroll") for (int i = 0; i < 16; ++i) vvb[buf][i] = z[(size_t)(r0 + tq * 16 + i) * 6144 + 2048 + head * 512 + (vsl_) * 128 + vv_]; } while (0)
    MLP_VLOAD(0, 0);
#pragma unroll
    for (int vsl = 0; vsl < 4; ++vsl) {
        if (vsl + 1 < 4) MLP_VLOAD((vsl + 1) & 1, vsl + 1);
#pragma unroll
        for (int i = 0; i < 16; i += 8) { const unsigned* vv = vvb[vsl & 1];
            u32x4 o = {vv[i] | (vv[i + 1] << 16), vv[i + 2] | (vv[i + 3] << 16), vv[i + 4] | (vv[i + 5] << 16), vv[i + 6] | (vv[i + 7] << 16)};
            *(u32x4*)(VTg + (size_t)(vsl * 128 + vv_) * LP + tq * 16 + i) = o; } }
#undef MLP_VLOAD
    float s0 = 0.f, s1 = 0.f;
#pragma unroll
    for (int i = 0; i < 16; i += 8) {
        unsigned k0[8], k1[8];
#pragma unroll
        for (int e = 0; e < 8; ++e) { const int t = tq * 16 + i + e; const float ka = bflo(kv[i + e]) * 0.0625f, kb = bfhi(kv[i + e]) * 0.0625f; const float wsv = __expf(__shfl(csv, t) - pmall);
            *(LAS unsigned*)(Q + t * QP + d2) = qv[i + e]; *(LAS unsigned*)(Kt + t * QP + d2) = cvt_pk_bf16(ka, kb); k0[e] = f2bf(ka * wsv); k1[e] = f2bf(kb * wsv); s0 += ka * wsv; s1 += kb * wsv; }
        u32x4 o0 = {k0[0] | (k0[1] << 16), k0[2] | (k0[3] << 16), k0[4] | (k0[5] << 16), k0[6] | (k0[7] << 16)};
        u32x4 o1 = {k1[0] | (k1[1] << 16), k1[2] | (k1[3] << 16), k1[4] | (k1[5] << 16), k1[6] | (k1[7] << 16)};
        *(u32x4*)(KTSg + (size_t)d2 * LP + tq * 16 + i) = o0; *(u32x4*)(KTSg + (size_t)(d2 + 1) * LP + tq * 16 + i) = o1; }
    T_KS[tq * 256 + d2] = s0; T_KS[tq * 256 + d2 + 1] = s1;
    __syncthreads();
    if (tid < 256) SCg[192 + tid] = (T_KS[tid] + T_KS[256 + tid]) + (T_KS[512 + tid] + T_KS[768 + tid]);
    for (int idx = w; idx < 12; idx += 8) {
        int tt, st; if (idx < 2) { tt = 0; st = idx; } else if (idx < 4) { tt = 1; st = idx - 2; } else if (idx < 8) { tt = 2; st = idx - 4; } else { tt = 3; st = idx - 8; }
        f32x4 acc = {0.f, 0.f, 0.f, 0.f}; const int t = tt * 16 + l16;
        if (st <= tt) {
#pragma unroll
            for (int ks = 0; ks < 8; ++ks) { const bf16x8 A = *(const LAS bf16x8*)(Kt + (st * 16 + l16) * QP + ks * 32 + quad * 8), B = *(const LAS bf16x8*)(Q + t * QP + ks * 32 + quad * 8);
                acc = MFMA16(A, B, acc); }
            const float pmt = T_PM[t]; const f32x4 cs4 = *(const LAS f32x4*)(T_CS + st * 16 + quad * 4);
#pragma unroll
            for (int j = 0; j < 4; ++j) acc[j] = (st * 16 + quad * 4 + j > t) ? 0.f : acc[j] * __expf(cs4[j] - pmt);
            float rs = (acc[0] + acc[1]) + (acc[2] + acc[3]); rs += __shfl_xor(rs, 16); rs += __shfl_xor(rs, 32);
            if (quad == 0) T_RS[t * 4 + st] = rs;
        }
        u32x2 o = {cvt_pk_bf16(acc[0], acc[1]), cvt_pk_bf16(acc[2], acc[3])};
        *(u32x2*)(SWg + (size_t)t * LP + st * 16 + quad * 4) = o;
    }
    __syncthreads();
    if (tid < 64) { const int tt = tid >> 4; float rs = 0.f;
#pragma unroll
        for (int st = 0; st < 4; ++st) if (st <= tt) rs += T_RS[tid * 4 + st];
        SCg[128 + tid] = rs; }
    __syncthreads();
}

__device__ __forceinline__ void ml_chain(LAS unsigned char* lds, const Params& P, int seq, int head, int vs, float* c_out, float* n_out, float* m_out) {
    constexpr int QP = 264, LP = 72;
    LAS bf16_t* KTS = (LAS bf16_t*)lds;
    LAS bf16_t* SW = (LAS bf16_t*)(lds + 36864);
    LAS bf16_t* VT = (LAS bf16_t*)(lds + 46080);
    LAS float* SC = (LAS float*)(lds + 64512);
    LAS bf16_t* Q = (LAS bf16_t*)(lds + 66560);
    LAS float* T_N = (LAS float*)(lds + 100352);
    LAS bf16_t* NA = (LAS bf16_t*)(lds + 101376);
    const int tid = threadIdx.x, lane = tid & 63, w = tid >> 6, quad = lane >> 4, l16 = lane & 15;
    const bf16_t* z = (const bf16_t*)(P.ws + OFF_Z);
    float* obuf = (float*)(P.ws + OFF_OBUF);
    const int vcol = vs * 128 + w * 16, row0 = seq * 2048;
    f32x4 C[16];
#pragma unroll
    for (int dt = 0; dt < 16; ++dt) C[dt] = (f32x4){0.f, 0.f, 0.f, 0.f};
    float nreg = 0.f, m = 0.f;
    if (tid < 256) { T_N[tid] = 0.f; NA[tid] = 0; }
    u32x4 pre[14];
#define MLC_LOAD(cc) do { const unsigned char* blob_ = ml_blob(P, seq, head, (cc)); \
        _Pragma("unroll") for (int i = 0; i < 6; ++i) { const int p = tid + 512 * i; if (p < 2880) pre[i] = *(const u32x4*)(blob_ + (size_t)p * 16); } \
        _Pragma("unroll") for (int i = 0; i < 3; ++i) { const int p = tid + 512 * i; if (p < 1152) pre[6 + i] = *(const u32x4*)(blob_ + MLB_VT + vs * 18432 + (size_t)p * 16); } \
        if (tid < 128) pre[9] = *(const u32x4*)(blob_ + MLB_SC + tid * 16); \
        _Pragma("unroll") for (int i = 0; i < 4; ++i) { const int p = tid + 512 * i; pre[10 + i] = *(const u32x4*)(z + (size_t)(row0 + (cc) * 64 + (p >> 5)) * 6144 + head * 256 + (p & 31) * 8); } } while (0)
    MLC_LOAD(0);
    for (int c = 0; c < 32; ++c) {
        const int r0 = row0 + c * 64;
#pragma unroll
        for (int i = 0; i < 6; ++i) { const int p = tid + 512 * i; if (p < 2880) *(LAS u32x4*)(lds + p * 16) = pre[i]; }
#pragma unroll
        for (int i = 0; i < 3; ++i) { const int p = tid + 512 * i; if (p < 1152) *(LAS u32x4*)(lds + 46080 + p * 16) = pre[6 + i]; }
        if (tid < 128) *(LAS u32x4*)(lds + 64512 + tid * 16) = pre[9];
#pragma unroll
        for (int i = 0; i < 4; ++i) { const int p = tid + 512 * i; *(LAS u32x4*)(Q + (p >> 5) * QP + (p & 31) * 8) = pre[10 + i]; }
        if (c + 1 < 32) MLC_LOAD(c + 1);
        __syncthreads();
        const float pmall = SC[448], blast = SC[449];
        const float mxall = fmaxf(m, pmall), decay = __expf(m - mxall), factor = __expf(pmall - mxall);
        const float ksum = tid < 256 ? SC[192 + tid] : 0.f;
        bf16x8 sa[8];
#pragma unroll
        for (int ks = 0; ks < 8; ++ks) sa[ks] = mk8(cvt_pk_bf16(C[2 * ks][0], C[2 * ks][1]), cvt_pk_bf16(C[2 * ks][2], C[2 * ks][3]), cvt_pk_bf16(C[2 * ks + 1][0], C[2 * ks + 1][1]), cvt_pk_bf16(C[2 * ks + 1][2], C[2 * ks + 1][3]));
        bf16x8 vt[2];
#pragma unroll
        for (int k2s = 0; k2s < 2; ++k2s) vt[k2s] = *(const LAS bf16x8*)(VT + (w * 16 + l16) * LP + k2s * 32 + quad * 8);
#pragma unroll
        for (int tt = 0; tt < 4; ++tt) {
            const int t = tt * 16 + l16; f32x4 ai = {0.f, 0.f, 0.f, 0.f}, an = {0.f, 0.f, 0.f, 0.f}, as = {0.f, 0.f, 0.f, 0.f};
#pragma unroll
            for (int ks = 0; ks < 8; ++ks) {
                const u32x2 lo = *(const LAS u32x2*)(Q + t * QP + ks * 32 + quad * 4), hi = *(const LAS u32x2*)(Q + t * QP + ks * 32 + 16 + quad * 4);
                const bf16x8 qB = mk8(lo.x, lo.y, hi.x, hi.y);
                bf16x8 na = mk8(0, 0, 0, 0); if (l16 == 0) na = *(const LAS bf16x8*)(NA + (ks * 4 + quad) * 8);
                ai = MFMA16(sa[ks], qB, ai); an = MFMA16(na, qB, an); }
#pragma unroll
            for (int k2s = 0; k2s < 2; ++k2s) if (2 * k2s <= tt) { const bf16x8 B = *(const LAS bf16x8*)(SW + t * LP + k2s * 32 + quad * 8); as = MFMA16(vt[k2s], B, as); }
            const float nq = __shfl(an[0], l16);
            const float pmt = SC[t], bt = SC[64 + t], rst = SC[128 + t];
            const float mx = fmaxf(m, pmt), rowfac = __expf(pmt - mx), gi = __expf(m - mx), emt = __expf(-(bt + mx));
            const float den = rst * rowfac + gi * nq, rd = 1.f / fmaxf(fabsf(den), emt);
            *(f32x4*)(obuf + (size_t)(r0 + t) * 2048 + head * 512 + vcol + quad * 4) = (as * rowfac + ai * gi) * rd;
        }
        if (pmall - m > -60.f) {
            const float dscale = __expf(m - pmall);
#pragma unroll
            for (int dt = 0; dt < 16; ++dt) { f32x4 acc = C[dt] * dscale;
#pragma unroll
                for (int k2s = 0; k2s < 2; ++k2s) { const bf16x8 A = *(const LAS bf16x8*)(KTS + (dt * 16 + l16) * LP + k2s * 32 + quad * 8); acc = MFMA16(A, vt[k2s], acc); }
                C[dt] = acc * factor; }
        }
        m = blast + mxall;
        __syncthreads();
        if (tid < 256) { nreg = decay * nreg + factor * ksum; T_N[tid] = nreg;
            const int dt = tid >> 4, q = (tid >> 2) & 3, j = tid & 3; NA[((dt >> 1) * 4 + q) * 8 + (dt & 1) * 4 + j] = f2bf(nreg); }
    }
#pragma unroll
    for (int dt = 0; dt < 16; ++dt) __builtin_nontemporal_store(C[dt], (f32x4*)(c_out + (size_t)(vcol + l16) * 256 + dt * 16 + quad * 4));
    if (vs == 0) { if (tid < 256) n_out[tid] = nreg; if (tid == 0) *m_out = m; }
    __syncthreads();
#undef MLC_LOAD
}

__device__ __forceinline__ void mixer0_phase(LAS unsigned char* lds, const Params& P) {
    const int b = blockIdx.x, G = gridDim.x, w = threadIdx.x >> 6;
    if (b < 32) {
        const int seq = b >> 3, head = (b >> 1) & 3, vs = b & 1;
        gla_unit<64>(lds, P, head, vs, seq * 2048, 32, 64, nullptr, P.out + O_GLAP + (size_t)(seq * 4 + head) * 32768);
    } else if (b < 64) {
        const int u = (b - 32) * 8 + w, seq = u >> 6, g = u & 63;
        s5_wave(lds + w * 12800, P, g, seq * 2048, 128, 16, nullptr, nullptr, P.out + O_S5REP + (size_t)(seq * 64 + g) * 64, P.out + O_S5IMP + (size_t)(seq * 64 + g) * 64);
    } else {
        for (int u = b - 64; u < 1024 + 128; u += G - 64) {
            if (u < 1024) { const int ss = u >> 3, head = (u >> 1) & 3, vs = u & 1;
                gla_unit<32>(lds, P, head, vs, NPROMPT + ss * 8, 1, 8, P.in[I_SGLA] + (size_t)(ss * 4 + head) * 32768, P.out + O_GLAS + (size_t)(ss * 4 + head) * 32768);
            } else { const int u2 = (u - 1024) * 8 + w, g = u2 & 63, ss0 = (u2 >> 6) * 8;
                s5_wave(lds + w * 12800, P, g, NPROMPT + ss0 * 8, 1, 8, P.in[I_SS5RE] + (size_t)(ss0 * 64 + g) * 64, P.in[I_SS5IM] + (size_t)(ss0 * 64 + g) * 64,
                        P.out + O_S5RES + (size_t)(ss0 * 64 + g) * 64, P.out + O_S5IMS + (size_t)(ss0 * 64 + g) * 64, 8, 8, 4096);
                __syncthreads(); }
        }
        conv_items(lds, P, CONV_EARLY, CONV_ALL, b - 64, G - 64);
    }
}
__device__ __forceinline__ void mixer1_phase(LAS unsigned char* lds, const Params& P) {
    const int b = blockIdx.x, G = gridDim.x;
    if (b < 64) {
        const int seq = b >> 4, head = (b >> 2) & 3, vs = b & 3;
        ml_chain(lds, P, seq, head, vs, P.out + O_MLCP + (size_t)(seq * 4 + head) * 131072, P.out + O_MLNP + (size_t)(seq * 4 + head) * 256, P.out + O_MLMP + seq * 4 + head);
    } else {
        for (int u = b - 64; u < 2048; u += G - 64) { const int ss = u >> 4, head = (u >> 2) & 3, vs = u & 3; const size_t sh = (size_t)(ss * 4 + head);
            ml_unit<32>(lds, P, head, vs, NPROMPT + ss * 8, 1, 8, P.in[I_SMLC] + sh * 131072, P.in[I_SMLN] + sh * 256, P.in[I_SMLM][sh], P.out + O_MLCS + sh * 131072, P.out + O_MLNS + sh * 256, P.out + O_MLMS + sh);
        }
    }
}
__device__ __forceinline__ void mlprep_phase(LAS unsigned char* lds, const Params& P) {
    for (int it = blockIdx.x; it < 512; it += gridDim.x) ml_prep(lds, P, it >> 7, (it >> 5) & 3, it & 31);
}
template <int HW>
__device__ __forceinline__ void post_phase(const Params& P) {
    const int lane = threadIdx.x & 63, w = threadIdx.x >> 6;
    const float* obuf = (const float*)(P.ws + OFF_OBUF); const bf16_t* z = (const bf16_t*)(P.ws + OFF_Z); bf16_t* mix = (bf16_t*)(P.ws + OFF_MIX);
    constexpr int NE = HW == 256 ? 4 : 8;
    const int ncol = HW == 256 ? 1024 : 2048, zp = HW == 256 ? 4096 : 6144, zoff = HW == 256 ? 2048 : 4096;
    const float* gsrc = HW == 256 ? P.in[I_GLANG] : P.in[I_MLONG];
    f32x4 g[NE];
#pragma unroll
    for (int e = 0; e < NE; ++e) g[e] = *(const f32x4*)(gsrc + e * 256 + lane * 4);
    for (int row = blockIdx.x * 8 + w; row < MROWS; row += gridDim.x * 8) {
        f32x4 o[NE]; u32x2 r[NE];
#pragma unroll
        for (int e = 0; e < NE; ++e) { o[e] = *(const f32x4*)(obuf + (size_t)row * 2048 + e * 256 + lane * 4); r[e] = *(const u32x2*)(z + (size_t)row * zp + zoff + e * 256 + lane * 4); }
        float ss[4];
#pragma unroll
        for (int h = 0; h < 4; ++h) { float a = 0.f;
#pragma unroll
            for (int e = h * (NE / 4); e < (h + 1) * (NE / 4); ++e) a += (o[e][0] * o[e][0] + o[e][1] * o[e][1]) + (o[e][2] * o[e][2] + o[e][3] * o[e][3]);
            ss[h] = a; }
#pragma unroll
        for (int of = 1; of < 64; of <<= 1) {
#pragma unroll
            for (int h = 0; h < 4; ++h) ss[h] += __shfl_xor(ss[h], of); }
#pragma unroll
        for (int e = 0; e < NE; ++e) { const float rs = rsqrtf(ss[e / (NE / 4)] * (1.f / HW) + EPS);
            float g0, g1, g2, g3;
            if (HW == 256) { g0 = siluf_(bflo(r[e].x)); g1 = siluf_(bfhi(r[e].x)); g2 = siluf_(bflo(r[e].y)); g3 = siluf_(bfhi(r[e].y)); }
            else { g0 = sigmoidf_(bflo(r[e].x)); g1 = sigmoidf_(bfhi(r[e].x)); g2 = sigmoidf_(bflo(r[e].y)); g3 = sigmoidf_(bfhi(r[e].y)); }
            u32x2 ov; ov.x = cvt_pk_bf16(o[e][0] * rs * g[e][0] * g0, o[e][1] * rs * g[e][1] * g1); ov.y = cvt_pk_bf16(o[e][2] * rs * g[e][2] * g2, o[e][3] * rs * g[e][3] * g3);
            *(u32x2*)(mix + (size_t)row * 2048 + e * 256 + lane * 4) = ov; }
        (void)ncol;
    }
}

__device__ __forceinline__ void upfix_phase(const Params& P) {
    const bf16_t* upart = (const bf16_t*)(P.ws + OFF_PART + 33554432); bf16_t* hh = (bf16_t*)(P.ws + OFF_HH);
    for (int it = blockIdx.x * NTHREADS + threadIdx.x; it < 48 * 256 * 16; it += gridDim.x * NTHREADS) {
        const int tr = it >> 12, rl = (it >> 4) & 255, jg = it & 15;
        const int pm = tr < 44 ? 35 : 34, pn = tr < 44 ? tr : 40 + (tr - 44);
        float a[8], b[8];
#pragma unroll
        for (int e = 0; e < 8; ++e) { a[e] = 0.f; b[e] = 0.f; }
#pragma unroll
        for (int ks = 0; ks < 4; ++ks) { const bf16_t* tb = upart + ((size_t)ks * 48 + tr) * 65536 + (size_t)rl * 256 + jg * 8;
            const u32x4 av = *(const u32x4*)tb, bv = *(const u32x4*)(tb + 128);
            a[0] += bflo(av.x); a[1] += bfhi(av.x); a[2] += bflo(av.y); a[3] += bfhi(av.y); a[4] += bflo(av.z); a[5] += bfhi(av.z); a[6] += bflo(av.w); a[7] += bfhi(av.w);
            b[0] += bflo(bv.x); b[1] += bfhi(bv.x); b[2] += bflo(bv.y); b[3] += bfhi(bv.y); b[4] += bflo(bv.z); b[5] += bfhi(bv.z); b[6] += bflo(bv.w); b[7] += bfhi(bv.w); }
        u32x4 o; o.x = cvt_pk_bf16(siluf_(a[0]) * b[0], siluf_(a[1]) * b[1]); o.y = cvt_pk_bf16(siluf_(a[2]) * b[2], siluf_(a[3]) * b[3]);
        o.z = cvt_pk_bf16(siluf_(a[4]) * b[4], siluf_(a[5]) * b[5]); o.w = cvt_pk_bf16(siluf_(a[6]) * b[6], siluf_(a[7]) * b[7]);
        *(u32x4*)(hh + (size_t)(pm * 256 + rl) * DFF + pn * 128 + jg * 8) = o;
    }
}
#define XB_TMO      128
#define XB_XCNT(j)  (256  + 64 * (j))
#define XB_XSUB(j)  (1280 + 64 * (j))
#define XB_XGEN(j)  (2304 + 64 * (j))
#define XB_TOP      3328
#define XB_TOPGEN   3392
#define XCD_BAR_WORDS 3456
#define XB_SPIN_CAP (1u << 22)
__device__ __forceinline__ unsigned xb_ld(unsigned* p)              { return __hip_atomic_load(p, __ATOMIC_RELAXED, __HIP_MEMORY_SCOPE_AGENT); }
__device__ __forceinline__ unsigned xb_add(unsigned* p, unsigned v) { return __hip_atomic_fetch_add(p, v, __ATOMIC_RELAXED, __HIP_MEMORY_SCOPE_AGENT); }
__device__ __forceinline__ unsigned xb_xcc_id() { return (unsigned)__builtin_amdgcn_s_getreg((3 << 11) | 20) & 0xFu; }
#define XB_SPIN(cond, bar) do { unsigned _sp = 0; while (cond) { __builtin_amdgcn_s_sleep(1); \
    if ((++_sp & 255u) == 0u) { if (xb_ld(&(bar)[XB_TMO])) break; if (_sp > XB_SPIN_CAP) { atomicAdd(&(bar)[XB_TMO], 1u); break; } } } } while (0)
struct XcdBarrier { unsigned* bar; unsigned x; volatile LAS unsigned* st; };
__device__ __forceinline__ XcdBarrier xcd_barrier_post(unsigned* bar, volatile LAS unsigned* st) {
    XcdBarrier b; b.bar = bar; b.x = xb_xcc_id(); b.st = st;
    if (threadIdx.x == 0) (void)xb_add(&bar[XB_XCNT(b.x)], 1u);
    return b;
}
__device__ __forceinline__ void xcd_barrier_complete(unsigned* bar, unsigned x, unsigned& nloc, unsigned& nx) {
    const unsigned G = gridDim.x * gridDim.y * gridDim.z;
    unsigned sum, cnt, mine, sp = 0u;
    for (;;) {
        sum = 0u; cnt = 0u; mine = 0u;
#pragma unroll
        for (unsigned j = 0; j < 16; ++j) { const unsigned c = xb_ld(&bar[XB_XCNT(j)]); sum += c; cnt += (c > 0u) ? 1u : 0u; mine = (j == x) ? c : mine; }
        if (sum == G) break;
        __builtin_amdgcn_s_sleep(1);
        if ((++sp & 255u) == 0u) { if (xb_ld(&bar[XB_TMO])) break; if (sp > XB_SPIN_CAP) { atomicAdd(&bar[XB_TMO], 1u); break; } }
    }
    nloc = mine > 0u ? mine : 1u; nx = cnt > 0u ? cnt : 1u;
}
__device__ __forceinline__ void xcd_barrier(const XcdBarrier& b) {
    asm volatile("s_waitcnt vmcnt(0)" ::: "memory");
    __syncthreads();
    if (threadIdx.x == 0) {
        unsigned* bar = b.bar;
        __builtin_amdgcn_s_waitcnt(0);
        unsigned nloc = b.st[0], nx = b.st[1];
        if (nloc == 0u) { xcd_barrier_complete(bar, b.x, nloc, nx); b.st[0] = nloc; b.st[1] = nx; }
        const unsigned old = xb_add(&bar[XB_XSUB(b.x)], 1u);
        const unsigned gen = old / nloc;
        if (old + 1u == (gen + 1u) * nloc) {
            __builtin_amdgcn_fence(__ATOMIC_RELEASE, "agent");
            asm volatile("s_waitcnt vmcnt(0)" ::: "memory");
            const unsigned og = xb_add(&bar[XB_TOP], 1u);
            const unsigned tg = og / nx;
            if (og + 1u == (tg + 1u) * nx) xb_add(&bar[XB_TOPGEN], 1u);
            else XB_SPIN(xb_ld(&bar[XB_TOPGEN]) == tg, bar);
            __builtin_amdgcn_fence(__ATOMIC_ACQUIRE, "agent");
            xb_add(&bar[XB_XGEN(b.x)], 1u);
            asm volatile("s_waitcnt vmcnt(0)" ::: "memory");
        } else {
            XB_SPIN(xb_ld(&bar[XB_XGEN(b.x)]) == gen, bar);
            __builtin_amdgcn_fence(__ATOMIC_ACQUIRE, "agent");
            asm volatile("s_waitcnt vmcnt(0)" ::: "memory");
        }
    }
    __syncthreads();
}

__global__ void __launch_bounds__(NTHREADS, 2) trunk_fwd(Params P) {
    extern __shared__ __attribute__((aligned(16))) unsigned char lds_raw[];
    LAS unsigned char* lds = (LAS unsigned char*)lds_raw;
    const int lo = P.ph_lo, hi = P.ph_hi;
    const int G = gridDim.x, bx = blockIdx.x;
    unsigned char* ws = P.ws;
    const float* mod = (const float*)(ws + OFF_MOD);
    float* xcur = (float*)(ws + OFF_XCUR);
    float* part = (float*)(ws + OFF_PART);
    bf16_t* hA = (bf16_t*)(ws + OFF_HA); bf16_t* z = (bf16_t*)(ws + OFF_Z); bf16_t* mix = (bf16_t*)(ws + OFF_MIX); bf16_t* hh = (bf16_t*)(ws + OFF_HH);
#ifndef PH_MASK
#define PH_MASK 0x7FFFF
#endif
#define IN(k) ((((PH_MASK) >> (k)) & 1) && lo <= (k) && (k) < hi)
    volatile LAS unsigned* xst = (volatile LAS unsigned*)(lds + LDS_BYTES - 64);
    XcdBarrier bar; bar.bar = (unsigned*)(ws + OFF_CTL); bar.x = 0; bar.st = xst;
    if (hi - lo > 1) { if (threadIdx.x < 2) xst[threadIdx.x] = 0u; __syncthreads(); bar = xcd_barrier_post((unsigned*)(ws + OFF_CTL), xst); }
    if (lo > 1000) cg::this_grid().sync();
#define SEAM(k) do { if (IN(k) && IN((k) + 1)) { xcd_barrier(bar); } } while (0)
#define GEMM(EPI, E, Aptr, Bptr, Mm, Nn, Kk) do { pg8::Gemm g_{(Aptr), (Bptr), (Mm), (Nn), (Kk)}; pg8::StaticOrder S_; S_.init((Mm), (Nn), (Kk), G, bx); pg8::gemm_phase<EPI, pg8::StaticOrder>(lds, g_, S_, E); } while (0)
#define GEMM_SPLIT(EPI, E, Aptr, Bptr, Kk) do { pg8::Gemm g_{(Aptr), (Bptr), MROWS, DM, (Kk)}; if (G == 256) { pg8::SplitOrder S_; S_.init((Kk), G, bx); pg8::gemm_phase<EPI, pg8::SplitOrder>(lds, g_, S_, E); } \
        else { pg8::StaticOrder S_; S_.init(MROWS, DM, (Kk), G, bx); pg8::gemm_phase<EPI, pg8::StaticOrder>(lds, g_, S_, E); } } while (0)
    if (IN(0)) { p0_prologue(lds, P); } SEAM(0);
    if (IN(1)) { EpiAda E{(float*)(ws + OFF_MOD), (const float*)(ws + OFF_BADA)};
                 GEMM(EpiAda, E, (const bf16_t*)(ws + OFF_CS), (const bf16_t*)(ws + OFF_WADA), 256, 6144, DM);
                 if (G > 24) { if (bx >= 24) conv_items(lds, P, 768, CONV_EARLY, bx - 24, G - 24); } else conv_items(lds, P, 768, CONV_EARLY, bx, G); } SEAM(1);
    if (IN(2)) { norm_phase<0>(lds, P, P.in[I_ABNG], 0, -1); } SEAM(2);
    if (IN(3)) { EpiBf16 E{z, 4096}; GEMM(EpiBf16, E, hA, (const bf16_t*)(ws + OFF_WABIN), MROWS, 4096, DM);
                 { const int rem_ = 576 % G; const int rk_ = bx - rem_, ng_ = G - rem_;
                   if (rk_ >= 0) { EpiAda E2{(float*)(ws + OFF_MOD) + 6144, (const float*)(ws + OFF_BADA) + 6144};
                       pg8::Gemm g2{(const bf16_t*)(ws + OFF_CS), (const bf16_t*)(ws + OFF_WADA) + (size_t)6144 * DM, 256, 18432, DM};
                       pg8::StaticOrder S2; S2.init(256, 18432, DM, ng_, rk_); pg8::gemm_phase<EpiAda, pg8::StaticOrder>(lds, g2, S2, E2); } } } SEAM(3);
    if (IN(4)) { mixer0_phase(lds, P); } SEAM(4);
    if (IN(5)) { post_phase<256>(P);
                 EpiGlu E{(const bf16_t*)(ws + OFF_YG), mix, P.in[I_S5BGLU]}; GEMM(EpiGlu, E, (const bf16_t*)(ws + OFF_YG), (const bf16_t*)(ws + OFF_WGLU), MROWS, 1024, 1024); } SEAM(5);
    if (IN(6)) { EpiResid E{P.in[I_XP], P.in[I_XS], xcur, mod + 0 * 6144 + 4096, part}; GEMM_SPLIT(EpiResid, E, mix, (const bf16_t*)(ws + OFF_WABOUT), DM); } SEAM(6);
    if (IN(7)) { norm_phase<1>(lds, P, P.in[I_FNG], 1, 0); } SEAM(7);
    if (IN(8)) { EpiSwiglu E{hh};
                 if (G == 256) { pg8::Gemm g_{hA, (const bf16_t*)(ws + OFF_WF13), MROWS, 11264, DM}; pg8::UpOrder S_; S_.init(DM, bx); pg8::gemm_phase<EpiSwiglu, pg8::UpOrder>(lds, g_, S_, E);
                                 EpiUpPart E2{(bf16_t*)(ws + OFF_PART + 33554432)}; pg8::UpRem S2; S2.init(DM, bx); pg8::gemm_phase<EpiUpPart, pg8::UpRem>(lds, g_, S2, E2);
                                 xcd_barrier(bar); upfix_phase(P); }
                 else GEMM(EpiSwiglu, E, hA, (const bf16_t*)(ws + OFF_WF13), MROWS, 11264, DM); } SEAM(8);
    if (IN(9)) { EpiResid E{xcur, xcur + (size_t)NPROMPT * DM, xcur, mod + 1 * 6144 + 4096, part}; GEMM_SPLIT(EpiResid, E, hh, (const bf16_t*)(ws + OFF_WF2), DFF); } SEAM(9);
    if (IN(10)) { norm_phase<2>(lds, P, P.in[I_MLNG], 2, 1); } SEAM(10);
    if (IN(11)) { EpiBf16 E{z, 6144}; GEMM(EpiBf16, E, hA, (const bf16_t*)(ws + OFF_WMLIN), MROWS, 6144, DM); } SEAM(11);
    if (IN(12)) { mlprep_phase(lds, P); xcd_barrier(bar); mixer1_phase(lds, P); } SEAM(12);
    if (IN(13)) { post_phase<512>(P); } SEAM(13);
    if (IN(14)) { EpiResid E{xcur, xcur + (size_t)NPROMPT * DM, xcur, mod + 2 * 6144 + 4096, part}; GEMM_SPLIT(EpiResid, E, mix, (const bf16_t*)(ws + OFF_WMLOUT), DM); } SEAM(14);
    if (IN(15)) { norm_phase<1>(lds, P, P.in[I_FNG] + DM, 3, 2); } SEAM(15);
    if (IN(16)) { EpiSwiglu E{hh};
                 if (G == 256) { pg8::Gemm g_{hA, (const bf16_t*)(ws + OFF_WF13) + (size_t)11264 * DM, MROWS, 11264, DM}; pg8::UpOrder S_; S_.init(DM, bx); pg8::gemm_phase<EpiSwiglu, pg8::UpOrder>(lds, g_, S_, E);
                                 EpiUpPart E2{(bf16_t*)(ws + OFF_PART + 33554432)}; pg8::UpRem S2; S2.init(DM, bx); pg8::gemm_phase<EpiUpPart, pg8::UpRem>(lds, g_, S2, E2);
                                 xcd_barrier(bar); upfix_phase(P); }
                 else GEMM(EpiSwiglu, E, hA, (const bf16_t*)(ws + OFF_WF13) + (size_t)11264 * DM, MROWS, 11264, DM); } SEAM(16);
    if (IN(17)) { EpiResid E{xcur, xcur + (size_t)NPROMPT * DM, xcur, mod + 3 * 6144 + 4096, part}; GEMM_SPLIT(EpiResid, E, hh, (const bf16_t*)(ws + OFF_WF2) + (size_t)DM * DFF, DFF); } SEAM(17);
    if (IN(18)) { norm_phase<3>(lds, P, P.in[I_FINALG], 0, 3); }
#undef IN
#undef SEAM
#undef GEMM
}

extern "C" void kernel_launch(void* const* d_in, const int* in_sizes, int n_in, void* d_out, int out_size, void* d_ws, size_t ws_size, hipStream_t stream) {
    static int grid = 0;
    if (grid == 0) {
        if (n_in != N_IN || (size_t)out_size != O_END || ws_size < WS_END) { fprintf(stderr, "kernel_launch: unexpected sizes n_in %d out %d ws %zu (need %d, %zu, %zu)\n", n_in, out_size, ws_size, (int)N_IN, (size_t)O_END, (size_t)WS_END); grid = -1; return; }
        int dev = 0, cus = 0, per_cu = 0;
        (void)hipGetDevice(&dev); (void)hipDeviceGetAttribute(&cus, hipDeviceAttributeMultiprocessorCount, dev);
        if (hipFuncSetAttribute((const void*)trunk_fwd, hipFuncAttributeMaxDynamicSharedMemorySize, LDS_BYTES) != hipSuccess) { fprintf(stderr, "kernel_launch: hipFuncSetAttribute failed\n"); grid = -1; return; }
        if (hipOccupancyMaxActiveBlocksPerMultiprocessor(&per_cu, (const void*)trunk_fwd, NTHREADS, LDS_BYTES) != hipSuccess || per_cu < 1) { fprintf(stderr, "kernel_launch: occupancy query says %d\n", per_cu); per_cu = 1; }
        (void)hipGetLastError();
        grid = cus * 1;
        if (grid < 128) { fprintf(stderr, "kernel_launch: grid %d too small\n", grid); grid = -1; return; }
    }
    if (grid < 0) return;
    Params p{};
    for (int i = 0; i < N_IN; ++i) p.in[i] = (const float*)d_in[i];
    p.out = (float*)d_out; p.ws = (unsigned char*)d_ws;
#if MK_PER_PHASE
    for (int ph = 0; ph < NPH; ++ph) { p.ph_lo = ph; p.ph_hi = ph + 1;
        hipLaunchKernelGGL(trunk_fwd, dim3(grid), dim3(NTHREADS), LDS_BYTES, stream, p);
        const hipError_t le = hipPeekAtLastError(); if (le != hipSuccess) { fprintf(stderr, "kernel_launch: launch %d failed: %s\n", ph, hipGetErrorName(le)); break; } }
#else
    p.ph_lo = 0; p.ph_hi = NPH;
    if (hipMemsetAsync((char*)d_ws + OFF_CTL, 0, CTL_BYTES, stream) != hipSuccess) { fprintf(stderr, "kernel_launch: memset failed\n"); return; }
    void* args[] = {&p};
    const hipError_t e = hipLaunchCooperativeKernel((const void*)trunk_fwd, dim3(grid), dim3(NTHREADS), args, LDS_BYTES, stream);
    if (e != hipSuccess) fprintf(stderr, "kernel_launch: cooperative launch failed: %s (grid %d)\n", hipGetErrorString(e), grid);
#endif
}
```
